# Optimizing an MI355X kernel written in HIP

```python
import math
import jax, jax.numpy as jnp
from jax import lax
import numpy as np

D_MODEL = 1024
BATCH = 8
SEQ = 2048
DEPTH = 4

HEAD_DIM = 64
BLOCK = 128
EPS = 1e-6
ROPE_BASE = 10000.0
A_HEADS = 6
A_KV_HEADS = 2
WINDOW = 128
B_HEADS = 6
B_KV_HEADS = 2
GRID_W = 64
C_HEADS = 4
C_Q_RANK = 256
C_KV_RANK = 128
C_NOPE = 64
C_ROPE = 32
C_V = 64
D_FF = 4 * D_MODEL

A_Q = A_HEADS * HEAD_DIM
A_KV = A_KV_HEADS * HEAD_DIM
B_Q = B_HEADS * HEAD_DIM
B_KV = B_KV_HEADS * HEAD_DIM
A_COLS = A_Q + 2 * A_KV
B_COLS = B_Q + 2 * B_KV
C_COLS = C_Q_RANK + C_KV_RANK + C_ROPE
IN_COLS = A_COLS + B_COLS + C_COLS
MIX_WIDTH = A_Q + B_Q + C_HEADS * C_V

kernel_name = "hybrid_parallel_heads_encoder"


def rmsnorm(x, g):
    xf = x.astype(jnp.float32)
    y = xf * lax.rsqrt(jnp.mean(xf * xf, axis=-1, keepdims=True) + EPS)
    return (y * g.astype(jnp.float32)).astype(x.dtype)


def rope_tables(pos, dim):
    inv = ROPE_BASE ** (-jnp.arange(0, dim, 2, dtype=jnp.float32) / dim)
    ang = pos.astype(jnp.float32)[:, None] * inv[None, :]
    ang = jnp.concatenate([ang, ang], axis=-1)
    return jnp.cos(ang), jnp.sin(ang)


def apply_rope(x, cos, sin):
    half = x.shape[-1] // 2
    x1, x2 = x[..., :half], x[..., half:]
    rot = jnp.concatenate([-x2, x1], axis=-1)
    return (x.astype(jnp.float32) * cos + rot.astype(jnp.float32) * sin).astype(x.dtype)


def alibi_slopes(n):
    return 2.0 ** (-8.0 * jnp.arange(1, n + 1, dtype=jnp.float32) / n)


def windowed_gqa_sink(q, k, v, sink):
    b, s, hq, d = q.shape
    hkv = k.shape[2]
    g = hq // hkv
    nb = s // BLOCK
    qb = q.reshape(b, nb, BLOCK, hkv, g, d)
    pad = ((0, 0), (BLOCK, BLOCK), (0, 0), (0, 0))
    kp = jnp.pad(k, pad).reshape(b, nb + 2, BLOCK, hkv, d)
    vp = jnp.pad(v, pad).reshape(b, nb + 2, BLOCK, hkv, d)
    kb = jnp.concatenate([kp[:, :-2], kp[:, 1:-1], kp[:, 2:]], axis=2)
    vb = jnp.concatenate([vp[:, :-2], vp[:, 1:-1], vp[:, 2:]], axis=2)
    sc = jnp.einsum('bnqhgd,bnkhd->bnhgqk', qb, kb).astype(jnp.float32) * (d ** -0.5)
    blk = jnp.arange(nb)[:, None] * BLOCK
    qpos = blk + jnp.arange(BLOCK)[None, :]
    kpos = blk - BLOCK + jnp.arange(3 * BLOCK)[None, :]
    dist = jnp.abs(qpos[:, :, None] - kpos[:, None, :])
    valid = (dist <= WINDOW) & ((kpos >= 0) & (kpos < s))[:, None, :]
    slopes = alibi_slopes(hq).reshape(hkv, g)
    bias = -slopes[None, :, :, None, None] * dist[:, None, None].astype(jnp.float32)
    sc = jnp.where(valid[:, None, None], sc + bias, -1e30)
    sk = sink.astype(jnp.float32).reshape(hkv, g)[:, :, None]
    m = jnp.maximum(jnp.max(sc, axis=-1), sk)
    p = jnp.exp(sc - m[..., None])
    probs = p / (jnp.sum(p, axis=-1) + jnp.exp(sk - m))[..., None]
    out = jnp.einsum('bnhgqk,bnkhd->bnqhgd', probs.astype(v.dtype), vb)
    return out.reshape(b, s, hq * d)


def dense_gqa_blocks(q, k, v):
    b, s, hq, d = q.shape
    hkv = k.shape[2]
    g = hq // hkv
    nb = s // BLOCK
    qb = q.reshape(b, nb, BLOCK, hkv, g, d).transpose(1, 0, 2, 3, 4, 5)

    def one(qblk):
        sc = jnp.einsum('bqhgd,bkhd->bhgqk', qblk, k).astype(jnp.float32) * (d ** -0.5)
        p = jax.nn.softmax(sc, axis=-1).astype(v.dtype)
        return jnp.einsum('bhgqk,bkhd->bqhgd', p, v)

    out = lax.map(one, qb)
    return out.transpose(1, 0, 2, 3, 4, 5).reshape(b, s, hq * d)


def mla_blocks(q_nope, q_rope, k_nope, k_rope, v):
    b, s, h, dn = q_nope.shape
    dr = q_rope.shape[-1]
    nb = s // BLOCK
    scale = (dn + dr) ** -0.5
    qn = q_nope.reshape(b, nb, BLOCK, h, dn).transpose(1, 0, 2, 3, 4)
    qr = q_rope.reshape(b, nb, BLOCK, h, dr).transpose(1, 0, 2, 3, 4)

    def one(args):
        qn_b, qr_b = args
        sc = (jnp.einsum('bqhd,bkhd->bhqk', qn_b, k_nope)
              + jnp.einsum('bqhd,bkd->bhqk', qr_b, k_rope)).astype(jnp.float32) * scale
        p = jax.nn.softmax(sc, axis=-1).astype(v.dtype)
        return jnp.einsum('bhqk,bkhd->bqhd', p, v)

    out = lax.map(one, (qn, qr))
    return out.transpose(1, 0, 2, 3, 4).reshape(b, s, h * v.shape[-1])


def setup_inputs(seed: int = 0) -> dict:
    key = jax.random.key(seed)
    ks = jax.random.split(key, 16)
    f32 = jnp.float32

    def nrm(k, shape, fan_in):
        return jax.random.normal(k, shape, f32) * (fan_in ** -0.5)

    def gain(k, shape):
        return 1.0 + 0.05 * jax.random.normal(k, shape, f32)

    return {
        "x": jax.random.normal(ks[0], (BATCH, SEQ, D_MODEL), f32),
        "attn_norm": gain(ks[1], (DEPTH, D_MODEL)),
        "w_in": nrm(ks[2], (DEPTH, D_MODEL, IN_COLS), D_MODEL),
        "a_sink": 0.5 * jax.random.normal(ks[3], (DEPTH, A_HEADS), f32),
        "b_q_norm": gain(ks[4], (DEPTH, HEAD_DIM)),
        "b_k_norm": gain(ks[5], (DEPTH, HEAD_DIM)),
        "c_q_norm": gain(ks[6], (DEPTH, C_Q_RANK)),
        "c_kv_norm": gain(ks[7], (DEPTH, C_KV_RANK)),
        "w_uq": nrm(ks[8], (DEPTH, C_Q_RANK, C_HEADS * (C_NOPE + C_ROPE)), C_Q_RANK),
        "w_ukv": nrm(ks[9], (DEPTH, C_KV_RANK, C_HEADS * (C_NOPE + C_V)), C_KV_RANK),
        "w_out": nrm(ks[10], (DEPTH, MIX_WIDTH, D_MODEL), MIX_WIDTH),
        "mlp_norm": gain(ks[11], (DEPTH, D_MODEL)),
        "w_ff1": nrm(ks[12], (DEPTH, D_MODEL, D_FF), D_MODEL),
        "w_ff2": nrm(ks[13], (DEPTH, D_FF, D_MODEL), D_FF),
        "final_norm": gain(ks[14], (D_MODEL,)),
    }


def reference(x, attn_norm, w_in, a_sink, b_q_norm, b_k_norm, c_q_norm, c_kv_norm,
              w_uq, w_ukv, w_out, mlp_norm, w_ff1, w_ff2, final_norm):
    b, s, _ = x.shape
    rows = s // GRID_W
    pos = jnp.arange(s)
    row_pos = jnp.repeat(jnp.arange(rows), GRID_W)
    col_pos = jnp.tile(jnp.arange(GRID_W), rows)
    half = HEAD_DIM // 2
    cos_r, sin_r = rope_tables(row_pos, half)
    cos_c, sin_c = rope_tables(col_pos, half)
    cos_m, sin_m = rope_tables(pos, C_ROPE)

    def axial(t):
        tr = apply_rope(t[..., :half], cos_r[:, None, :], sin_r[:, None, :])
        tc = apply_rope(t[..., half:], cos_c[:, None, :], sin_c[:, None, :])
        return jnp.concatenate([tr, tc], axis=-1)

    o1 = A_Q
    o2 = o1 + A_KV
    o3 = o2 + A_KV
    o4 = o3 + B_Q
    o5 = o4 + B_KV
    o6 = o5 + B_KV
    o7 = o6 + C_Q_RANK
    o8 = o7 + C_KV_RANK

    for l in range(DEPTH):
        h = rmsnorm(x, attn_norm[l])
        p = h @ w_in[l]

        qa = p[..., :o1].reshape(b, s, A_HEADS, HEAD_DIM)
        ka = p[..., o1:o2].reshape(b, s, A_KV_HEADS, HEAD_DIM)
        va = p[..., o2:o3].reshape(b, s, A_KV_HEADS, HEAD_DIM)
        out_a = windowed_gqa_sink(qa, ka, va, a_sink[l])

        qb = rmsnorm(p[..., o3:o4].reshape(b, s, B_HEADS, HEAD_DIM), b_q_norm[l])
        kb = rmsnorm(p[..., o4:o5].reshape(b, s, B_KV_HEADS, HEAD_DIM), b_k_norm[l])
        vb = p[..., o5:o6].reshape(b, s, B_KV_HEADS, HEAD_DIM)
        out_b = dense_gqa_blocks(axial(qb), axial(kb), vb)

        cq = rmsnorm(p[..., o6:o7], c_q_norm[l]) @ w_uq[l]
        cq = cq.reshape(b, s, C_HEADS, C_NOPE + C_ROPE)
        q_nope = cq[..., :C_NOPE]
        q_rope = apply_rope(cq[..., C_NOPE:], cos_m[:, None, :], sin_m[:, None, :])
        ckv = rmsnorm(p[..., o7:o8], c_kv_norm[l]) @ w_ukv[l]
        ckv = ckv.reshape(b, s, C_HEADS, C_NOPE + C_V)
        k_nope = ckv[..., :C_NOPE]
        vc = ckv[..., C_NOPE:]
        k_rope = apply_rope(p[..., o8:], cos_m, sin_m)
        out_c = mla_blocks(q_nope, q_rope, k_nope, k_rope, vc)

        mixed = jnp.concatenate([out_a, out_b, out_c], axis=-1)
        x = x + mixed @ w_out[l]

        h2 = rmsnorm(x, mlp_norm[l])
        x = x + jnp.square(jax.nn.relu(h2 @ w_ff1[l])) @ w_ff2[l]

    return rmsnorm(x, final_norm)
```

```cpp
#include <hip/hip_runtime.h>
#include <hip/hip_cooperative_groups.h>
#include <cstdio>
#include <cstdint>
namespace cg = cooperative_groups;

#define LAS __attribute__((address_space(3)))
typedef unsigned short bf16_t;
typedef short bf16x8 __attribute__((ext_vector_type(8)));
typedef short s16x4 __attribute__((ext_vector_type(4)));
typedef float f32x4 __attribute__((ext_vector_type(4)));
typedef float f32x2 __attribute__((ext_vector_type(2)));
typedef float f32x16 __attribute__((ext_vector_type(16)));
typedef unsigned u32x4 __attribute__((ext_vector_type(4)));
typedef unsigned u32x2 __attribute__((ext_vector_type(2)));

constexpr int BATCH = 8, SEQ = 2048, DM = 1024, DEPTH = 4, FF = 4096;
constexpr int M = BATCH * SEQ;
constexpr int IN_COLS = 1696, PLD = 1792;
constexpr int CQ_LD = 512, CKV_LD = 512;
constexpr float EPS = 1e-6f;
constexpr float LOG2E = 1.4426950408889634f;
constexpr int A_Q0 = 0, A_K0 = 384, A_V0 = 512, B_Q0 = 640, B_K0 = 1024, B_V0 = 1152, C_Q0 = 1280, C_KV0 = 1536, C_R0 = 1664;

constexpr size_t MiB = 1u << 20;
constexpr size_t WS_CTL = 0, CTL_BYTES = 131072;
constexpr int CW_BAR = 4096, CW_BAR2 = 8192, CW_BAR3 = 12288;
constexpr int CW_GP = 24576, CW_GA = 25600;
constexpr int CW_Q = 64;
constexpr size_t WS_ROPE = 1 * MiB;
constexpr size_t WS_SSA = 1 * MiB + 256 * 1024, WS_SSM = WS_SSA + (size_t)M * 16 * 4, WS_SSCQ = WS_SSM + (size_t)M * 16 * 4, WS_SSCKV = WS_SSCQ + (size_t)M * 4 * 4, WS_SS_END = WS_SSCKV + (size_t)M * 2 * 4;
constexpr size_t WS_W = 4 * MiB, W_LAYER = 22 * MiB;
constexpr size_t WO_IN = 0, WO_UQ = WO_IN + (size_t)PLD * DM * 2, WO_UKV = WO_UQ + 512 * 256 * 2, WO_OUT = WO_UKV + 512 * 256 * 2,
                 WO_FF1 = WO_OUT + (size_t)DM * DM * 2, WO_FF2 = WO_FF1 + (size_t)FF * DM * 2, WO_END = WO_FF2 + (size_t)FF * DM * 2;
static_assert(WO_END <= W_LAYER, "weights per layer");
static_assert(WS_SS_END <= WS_W, "ss arrays");
constexpr size_t WS_XN = WS_W + DEPTH * W_LAYER;
constexpr size_t WS_U = WS_XN + (size_t)M * DM * 2;
constexpr size_t BLK = 2 * MiB, BLKE = BLK / 2;
constexpr size_t SUB_P = 0, SUB_CQ = SUB_P + 256 * (size_t)PLD * 2, SUB_CKV = SUB_CQ + 256 * (size_t)CQ_LD * 2, SUB_MIX = SUB_CKV + 256 * (size_t)CKV_LD * 2;
static_assert(SUB_MIX + 256 * (size_t)DM * 2 <= BLK && 256 * (size_t)FF * 2 == BLK, "row-block overlay");
constexpr size_t WS_END = WS_U + (size_t)M * FF * 2;
static_assert(WS_END <= 256 * MiB, "d_ws map");

typedef __bf16 bf16x2_t __attribute__((ext_vector_type(2)));
__device__ __forceinline__ unsigned cvt_pk_bf16(float lo, float hi) { const f32x2 v = {lo, hi}; const bf16x2_t b = __builtin_convertvector(v, bf16x2_t); return __builtin_bit_cast(unsigned, b); }
__device__ __forceinline__ unsigned f2bf(float f) { unsigned u = __builtin_bit_cast(unsigned, f); return (u + 0x7fffu + ((u >> 16) & 1u)) >> 16; }
__device__ __forceinline__ unsigned pk2(float lo, float hi) { return f2bf(lo) | (f2bf(hi) << 16); }
__device__ __forceinline__ float bf2f(unsigned b) { return __builtin_bit_cast(float, b << 16); }

template <int NP> __device__ __forceinline__ float ss_sum(const float* p) {
    if constexpr (NP == 2) { const f32x2 a = *(const f32x2*)p; return a.x + a.y; }
    else { float t = 0.f;
#pragma unroll
        for (int j = 0; j < NP / 4; ++j) { const f32x4 a = *(const f32x4*)(p + 4 * j); t += (a.x + a.y) + (a.z + a.w); }
        return t; }
}
__device__ __forceinline__ void quad_arrive(unsigned* arr);
namespace pg8 {
constexpr int BM = 256, BK = 64, HALF = 128, HTB = HALF * BK * 2, STAGE_BYTES = 8 * HTB, NXCD = 8, WGM = 8;
__host__ __device__ __forceinline__ int lds_byte(int r, int c) { const int st = (r >> 4) * 2 + (c >> 5), rr = r & 15, cc = c & 31, ob = rr * 64 + cc * 2; return st * 1024 + (ob ^ (((ob >> 9) & 1) << 5)); }
__host__ __device__ __forceinline__ void stage_rc(int b, int& R, int& C) { const int st = b / 1024, sb = b % 1024, swz = sb ^ (((sb >> 9) & 1) << 5); R = (st >> 1) * 16 + swz / 64; C = (st & 1) * 32 + (swz % 64) / 2; }
__host__ __device__ __forceinline__ int perm32(int rho) { const int n = rho >> 4, i = rho & 15; return 8 * (i >> 2) + 4 * n + (i & 3); }

struct Unit { int pm, pn; };
struct Gemm { const bf16_t* A; const bf16_t* Bt; int M, N, K, lda; size_t astep; };

struct GroupOrder {
    int nunits, r, gsize, pm0;
    __device__ void init(int N_, int b, int r_, int gsize_) { nunits = 8 * (N_ / BM); r = r_; gsize = gsize_; pm0 = 8 * b; }
    __device__ bool next(int i, Unit& u) const { const int L = i * gsize + r; if (L >= nunits) return false; u.pm = pm0 + (L & 7); u.pn = L >> 3; return true; }
};
struct G1Order {
    int r, pm0;
    __device__ bool next(int i, Unit& u) const { if (i > 1) return false; const int L = i * 32 + r; if (L >= 56) return false; u.pm = pm0 + (r & 7); u.pn = ((L >> 3) + 5) % 7; return true; }
};
struct PairOrder { int pm, pn0, cnt; __device__ bool next(int i, Unit& u) const { if (i >= cnt) return false; u.pm = pm; u.pn = pn0 + i; return true; } };

constexpr float C2_A = 0.125f * LOG2E, C2_B = 0.125f * LOG2E, C2_C = 0.10206207261596575f * LOG2E;
template <int ACT  , int NP> struct EpiBf16 {
    static constexpr int BMAP = 1;
    bf16_t* O; int ldc; const float* ss; float inv_n; const LAS float* rsl;
    __device__ __forceinline__ void operator()(const f32x4 (&acc)[2][2][4][2], const Unit& u, int wr, int wc, int fr, int fq) const {
        const int row0 = u.pm * BM + wr * 64 + fr; const int col0 = u.pn * BM + wc * 32 + 8 * fq;
#pragma unroll
        for (int ai = 0; ai < 2; ++ai)
#pragma unroll
            for (int m = 0; m < 4; ++m) { const int row = row0 + ai * HALF + m * 16; bf16_t* rowp = O + (size_t)u.pm * BLKE + (size_t)(row & 255) * ldc + col0;
                float rs; if constexpr (NP == 0) rs = rsl[row & 255]; else rs = rsqrtf(ss_sum<NP>(ss + (size_t)row * NP) * inv_n + EPS);
#pragma unroll
                for (int bj = 0; bj < 2; ++bj) { f32x4 v0 = acc[ai][bj][m][0] * rs, v1 = acc[ai][bj][m][1] * rs;
                    if (ACT == 2) {
#pragma unroll
                        for (int i = 0; i < 4; ++i) { float a = fmaxf(v0[i], 0.f), b = fmaxf(v1[i], 0.f); v0[i] = a * a; v1[i] = b * b; } }
                    u32x4 w; w.x = cvt_pk_bf16(v0[0], v0[1]); w.y = cvt_pk_bf16(v0[2], v0[3]); w.z = cvt_pk_bf16(v1[0], v1[1]); w.w = cvt_pk_bf16(v1[2], v1[3]);
                    *(u32x4*)(rowp + bj * HALF) = w; } }
    }
};
struct EpiRes {
    static constexpr int BMAP = 1;
    const float* base; float* out; bf16_t* xb; float* ssn; int ldc; bool ntb;
    __device__ __forceinline__ void operator()(const f32x4 (&acc)[2][2][4][2], const Unit& u, int wr, int wc, int fr, int fq) const {
        const int row0 = u.pm * BM + wr * 64 + fr; const int col0 = u.pn * BM + wc * 32 + 8 * fq;
#pragma unroll
        for (int ai = 0; ai < 2; ++ai)
#pragma unroll
            for (int m = 0; m < 4; ++m) { const int row = row0 + ai * HALF + m * 16; const size_t off = (size_t)row * ldc + col0; float sq = 0.f;
#pragma unroll
                for (int bj = 0; bj < 2; ++bj) { f32x4 b0, b1; const f32x4* bp = (const f32x4*)(base + off + bj * HALF);
                    if (ntb) { b0 = __builtin_nontemporal_load(bp); b1 = __builtin_nontemporal_load(bp + 1); } else { b0 = bp[0]; b1 = bp[1]; }
                    const f32x4 o0 = b0 + acc[ai][bj][m][0], o1 = b1 + acc[ai][bj][m][1];
                    *(f32x4*)(out + off + bj * HALF) = o0; *(f32x4*)(out + off + bj * HALF + 4) = o1;
                    sq += ((o0[0] * o0[0] + o0[1] * o0[1]) + (o0[2] * o0[2] + o0[3] * o0[3])) + ((o1[0] * o1[0] + o1[1] * o1[1]) + (o1[2] * o1[2] + o1[3] * o1[3]));
                    u32x4 w; w.x = cvt_pk_bf16(o0[0], o0[1]); w.y = cvt_pk_bf16(o0[2], o0[3]); w.z = cvt_pk_bf16(o1[0], o1[1]); w.w = cvt_pk_bf16(o1[2], o1[3]);
                    *(u32x4*)(xb + off + bj * HALF) = w; }
                sq += __shfl_xor(sq, 16); sq += __shfl_xor(sq, 32);
                if (fq == 0) ssn[(size_t)row * 16 + u.pn * 4 + wc] = sq;
                if (m & 1) asm volatile("" ::: "memory"); }
    }
};
struct EpiRope {
    static constexpr int BMAP = 0;
    bf16_t* O; int ldc; const f32x2* rope; const float* ss;
    __device__ __forceinline__ void operator()(const f32x4 (&acc)[2][2][4][2], const Unit& u, int wr, int wc, int fr, int fq) const {
        const int row0 = u.pm * BM + wr * 64 + fr; const int col0 = u.pn * BM + wc * 32 + 4 * fq;
#pragma unroll
        for (int ai = 0; ai < 2; ++ai)
#pragma unroll
            for (int m = 0; m < 4; ++m) { const int row = row0 + ai * HALF + m * 16; const int t = row & (SEQ - 1);
                const float rs = rsqrtf(ss_sum<4>(ss + (size_t)row * 4) * (1.f / 256.f) + EPS) * C2_C;
                const f32x4 cs0 = *(const f32x4*)(rope + (size_t)t * 16 + 4 * fq), cs1 = *(const f32x4*)(rope + (size_t)t * 16 + 4 * fq + 2);
                const float cc[4] = {cs0[0], cs0[2], cs1[0], cs1[2]}, sn[4] = {cs0[1], cs0[3], cs1[1], cs1[3]};
#pragma unroll
                for (int bj = 0; bj < 2; ++bj) { const int g32 = u.pn * 8 + bj * 4 + wc; f32x4 a = acc[ai][bj][m][0] * rs, b = acc[ai][bj][m][1] * rs;
                    if (g32 < 12 && (g32 % 3) == 2) {
#pragma unroll
                        for (int i = 0; i < 4; ++i) { const float x1 = a[i], x2 = b[i]; a[i] = x1 * cc[i] - x2 * sn[i]; b[i] = x2 * cc[i] + x1 * sn[i]; } }
                    bf16_t* p = O + (size_t)u.pm * BLKE + (size_t)(row & 255) * ldc + col0 + bj * HALF;
                    u32x2 w0, w1; w0.x = cvt_pk_bf16(a[0], a[1]); w0.y = cvt_pk_bf16(a[2], a[3]); w1.x = cvt_pk_bf16(b[0], b[1]); w1.y = cvt_pk_bf16(b[2], b[3]);
                    *(u32x2*)p = w0; *(u32x2*)(p + 16) = w1; }
                asm volatile("" ::: "memory"); }
    }
};
struct EpiG1 {
    static constexpr int BMAP = 3;
    bf16_t* O; const LAS float* rsl; float* sscq; float* ssckv; const float* gq; const float* gk; const f32x2* rope;
    __device__ __forceinline__ void operator()(const f32x4 (&acc)[2][2][4][2], const Unit& u, int wr, int wc, int fr, int fq) const {
        const int g64 = u.pn * 4 + wc;
        const int row0 = u.pm * BM + wr * 64 + fr; const int lc = 8 * (fq & 1) + 32 * (fq >> 1);
        const bool isBq = (g64 >= 10 && g64 < 16), isBk = (g64 == 16 || g64 == 17), isNorm = isBq || isBk, isLat = (g64 >= 20 && g64 < 26), isKr = (g64 == 26);
        f32x4 gn[2][2];
#pragma unroll
        for (int bj = 0; bj < 2; ++bj)
#pragma unroll
            for (int n = 0; n < 2; ++n) gn[bj][n] = (f32x4){1.f, 1.f, 1.f, 1.f};
        if (isNorm) { const float* gp = (isBq ? gq : gk) + lc; const float sc = isBq ? C2_B : 1.f;
#pragma unroll
            for (int bj = 0; bj < 2; ++bj)
#pragma unroll
                for (int n = 0; n < 2; ++n) gn[bj][n] = *(const f32x4*)(gp + 4 * bj + 16 * n) * sc; }
        const float pre = (g64 < 6) ? C2_A : 1.f;
        const bool ropeLane = isNorm || (isKr && (fq >> 1) == 0);
#pragma unroll
        for (int ai = 0; ai < 2; ++ai)
#pragma unroll
            for (int m = 0; m < 4; ++m) { const int row = row0 + ai * HALF + m * 16; const int t = row & (SEQ - 1);
                const float rs = rsl[row & 255] * pre;
                f32x4 v[2][2];
#pragma unroll
                for (int bj = 0; bj < 2; ++bj)
#pragma unroll
                    for (int n = 0; n < 2; ++n) v[bj][n] = acc[ai][bj][m][n] * rs;
                if (isNorm || isLat) {
                    float sq = 0.f;
#pragma unroll
                    for (int bj = 0; bj < 2; ++bj)
#pragma unroll
                        for (int n = 0; n < 2; ++n) sq += (v[bj][n][0] * v[bj][n][0] + v[bj][n][1] * v[bj][n][1]) + (v[bj][n][2] * v[bj][n][2] + v[bj][n][3] * v[bj][n][3]);
                    sq += __shfl_xor(sq, 16); sq += __shfl_xor(sq, 32);
                    if (isLat) { if (fq == 0) { if (g64 < 24) sscq[(size_t)row * 4 + (g64 - 20)] = sq; else ssckv[(size_t)row * 2 + (g64 - 24)] = sq; } }
                    else { const float r2 = rsqrtf(sq * (1.f / 64.f) + EPS);
#pragma unroll
                        for (int bj = 0; bj < 2; ++bj)
#pragma unroll
                            for (int n = 0; n < 2; ++n) v[bj][n] = v[bj][n] * r2 * gn[bj][n]; }
                }
                if (isNorm || isKr) {
                    const int pos = isKr ? t : ((fq >> 1) ? (t & 63) : (t >> 6));
                    const f32x2* rp = rope + (size_t)pos * 16 + 8 * (fq & 1);
#pragma unroll
                    for (int bj = 0; bj < 2; ++bj) {
                        const f32x4 cs0 = *(const f32x4*)(rp + 4 * bj), cs1 = *(const f32x4*)(rp + 4 * bj + 2);
                        const float cc[4] = {cs0[0], cs0[2], cs1[0], cs1[2]}, sn[4] = {cs0[1], cs0[3], cs1[1], cs1[3]};
#pragma unroll
                        for (int i = 0; i < 4; ++i) { const float x1 = v[bj][0][i], x2 = v[bj][1][i]; const float y1 = x1 * cc[i] - x2 * sn[i], y2 = x2 * cc[i] + x1 * sn[i];
                            v[bj][0][i] = ropeLane ? y1 : x1; v[bj][1][i] = ropeLane ? y2 : x2; }
                    }
                }
                bf16_t* p = O + (size_t)u.pm * BLKE + (size_t)(row & 255) * PLD + g64 * 64 + lc;
#pragma unroll
                for (int n = 0; n < 2; ++n) { u32x4 w; w.x = cvt_pk_bf16(v[0][n][0], v[0][n][1]); w.y = cvt_pk_bf16(v[0][n][2], v[0][n][3]); w.z = cvt_pk_bf16(v[1][n][0], v[1][n][1]); w.w = cvt_pk_bf16(v[1][n][2], v[1][n][3]);
                    *(u32x4*)(p + 16 * n) = w; }
                asm volatile("" ::: "memory"); }
    }
};

template <class Epi, class Sched>
__device__ __forceinline__ void gemm_phase(LAS unsigned char* lds, const Gemm g, const Sched& S, const Epi& E, const float* rs_src = nullptr, LAS float* rs_dst = nullptr, unsigned* arr_first = nullptr) {
    int tid = threadIdx.x; asm volatile("" : "+v"(tid));
    const int wid = __builtin_amdgcn_readfirstlane(tid >> 6), lane = tid & 63, wr = wid >> 2, wc = wid & 3, fr = lane & 15, fq = lane >> 4;
    int K = g.K, lda = g.lda; asm volatile("" : "+s"(K), "+s"(lda)); const int nt = K / BK;
    unsigned voffA[2], voffB[2];
#pragma unroll
    for (int i = 0; i < 2; ++i) { int R, C; stage_rc(tid * 16 + i * 8192, R, C); const int Rb = (Epi::BMAP == 1) ? ((R & ~31) + perm32(R & 31)) : (Epi::BMAP == 3) ? (64 * (R >> 5) + (R & 3) + 8 * ((R >> 2) & 1) + 16 * ((R >> 4) & 1) + 32 * ((R >> 3) & 1)) : R;
        voffA[i] = (unsigned)(R * lda + C) * 2u; voffB[i] = (unsigned)(Rb * K + C) * 2u; }
    const size_t kstep = (size_t)(BK * 2);
    const size_t hstepA = (size_t)HALF * lda * 2, hstepB = (size_t)((Epi::BMAP == 3) ? 4 : HALF) * K * 2;
    const size_t tstepA = g.astep, tstepB = (size_t)BM * K * 2;
    const unsigned ldsw = (unsigned)wid * 1024u;
    const int aoff = lds_byte(wr * 64 + fr, fq * 8), boff = lds_byte(wc * 32 + fr, fq * 8);
#define PG8_SA(b, h) (((b) * 2 + (h)) * HTB)
#define PG8_SB(b, h) ((4 + (b) * 2 + (h)) * HTB)
#define PG8_STAGE(bufoff, gbase, voff) do { _Pragma("unroll") for (int _i = 0; _i < 2; ++_i) \
        __builtin_amdgcn_global_load_lds((const unsigned*)((const char*)(gbase) + (voff)[_i]), (LAS unsigned*)(lds + (bufoff) + ldsw + _i * 8192), 16, 0, 0); } while (0)
#define PG8_LDA(dst, b, h) do { _Pragma("unroll") for (int m = 0; m < 4; ++m) _Pragma("unroll") for (int k = 0; k < 2; ++k) dst[m][k] = *(const LAS bf16x8*)(lds + PG8_SA(b, h) + aoff + m * 2048 + k * 1024); } while (0)
#define PG8_LDB(dst, b, h) do { _Pragma("unroll") for (int n = 0; n < 2; ++n) _Pragma("unroll") for (int k = 0; k < 2; ++k) dst[n][k] = *(const LAS bf16x8*)(lds + PG8_SB(b, h) + boff + n * 2048 + k * 1024); } while (0)
#define PG8_MMA(ai, bj, At, Bt) do { __builtin_amdgcn_s_setprio(1); _Pragma("unroll") for (int m = 0; m < 4; ++m) _Pragma("unroll") for (int n = 0; n < 2; ++n) _Pragma("unroll") for (int k = 0; k < 2; ++k) \
        acc[ai][bj][m][n] = __builtin_amdgcn_mfma_f32_16x16x32_bf16(Bt[n][k], At[m][k], acc[ai][bj][m][n], 0, 0, 0); __builtin_amdgcn_s_setprio(0); } while (0)
#define PG8_WAIT_V(n) asm volatile("s_waitcnt vmcnt(" #n ")" ::: "memory")
#define PG8_WAIT_L(n) asm volatile("s_waitcnt lgkmcnt(" #n ")" ::: "memory")
#define PG8_BAR __builtin_amdgcn_s_barrier()
#define PG8_SCHED __builtin_amdgcn_sched_barrier(0)
    Unit cur, nxt; int ui = 0;
    if (!S.next(0, cur)) return;
    f32x4 acc[2][2][4][2];
#pragma unroll
    for (int a = 0; a < 2; ++a)
#pragma unroll
        for (int b = 0; b < 2; ++b)
#pragma unroll
            for (int m = 0; m < 4; ++m)
#pragma unroll
                for (int n = 0; n < 2; ++n) acc[a][b][m][n] = (f32x4){0.f, 0.f, 0.f, 0.f};
    bf16x8 At[4][2], B0[2][2], B1[2][2];
    const char* cA = (const char*)g.A + (size_t)cur.pm * tstepA; const char* cB = (const char*)g.Bt + (size_t)cur.pn * tstepB;
    PG8_STAGE(PG8_SB(0, 0), cB, voffB); PG8_STAGE(PG8_SB(0, 1), cB + hstepB, voffB); PG8_STAGE(PG8_SA(0, 0), cA, voffA); PG8_STAGE(PG8_SA(0, 1), cA + hstepA, voffA);
    f32x4 rsv[4] = {(f32x4){0.f, 0.f, 0.f, 0.f}, (f32x4){0.f, 0.f, 0.f, 0.f}, (f32x4){0.f, 0.f, 0.f, 0.f}, (f32x4){0.f, 0.f, 0.f, 0.f}};
    const bool rs_on = (rs_src != nullptr) && (wr == 0);
    if (rs_on) { const f32x4* rp = (const f32x4*)(rs_src + (size_t)tid * 16); rsv[0] = rp[0]; rsv[1] = rp[1]; rsv[2] = rp[2]; rsv[3] = rp[3]; }
    if (wr == 1) PG8_BAR;
    PG8_WAIT_V(2); PG8_BAR;
    PG8_STAGE(PG8_SB(1, 0), cB + kstep, voffB); PG8_STAGE(PG8_SA(1, 0), cA + kstep, voffA); PG8_STAGE(PG8_SB(1, 1), cB + hstepB + kstep, voffB);
    PG8_WAIT_V(6); PG8_BAR;
    if (rs_on) { float t_ = 0.f;
#pragma unroll
        for (int j = 0; j < 4; ++j) t_ += (rsv[j].x + rsv[j].y) + (rsv[j].z + rsv[j].w);
        rs_dst[tid] = rsqrtf(t_ * (1.f / DM) + EPS); }
    for (;;) {
        const bool has_next = S.next(ui + 1, nxt);
        const char* nA = has_next ? (const char*)g.A + (size_t)nxt.pm * tstepA : cA; const char* nB = has_next ? (const char*)g.Bt + (size_t)nxt.pn * tstepB : cB;
        for (int t = 0; t < nt; t += 2) {
            const bool last = (t == nt - 2);
            const char* a1 = cA + (size_t)(t + 1) * kstep;
            const char* a2 = last ? nA : cA + (size_t)(t + 2) * kstep; const char* b2 = last ? nB : cB + (size_t)(t + 2) * kstep;
            const char* a3 = a2 + kstep; const char* b3 = b2 + kstep;
            PG8_LDB(B0, 0, 0); PG8_LDB(B1, 0, 1); PG8_SCHED; PG8_LDA(At, 0, 0); PG8_STAGE(PG8_SA(1, 1), a1 + hstepA, voffA);
            PG8_WAIT_V(8); PG8_WAIT_L(0); PG8_BAR; PG8_MMA(0, 0, At, B0); PG8_MMA(0, 1, At, B1); PG8_BAR; PG8_SCHED;
            PG8_LDA(At, 0, 1); PG8_STAGE(PG8_SB(0, 0), b2, voffB); PG8_STAGE(PG8_SB(0, 1), b2 + hstepB, voffB); PG8_STAGE(PG8_SA(0, 0), a2, voffA);
            PG8_WAIT_V(8); PG8_WAIT_L(0); PG8_BAR; PG8_MMA(1, 0, At, B0); PG8_MMA(1, 1, At, B1); PG8_BAR; PG8_SCHED;
            PG8_LDB(B0, 1, 0); PG8_LDB(B1, 1, 1); PG8_SCHED; PG8_LDA(At, 1, 0); PG8_STAGE(PG8_SA(0, 1), a2 + hstepA, voffA);
            PG8_WAIT_V(8); PG8_WAIT_L(0); PG8_BAR; PG8_MMA(0, 0, At, B0); PG8_MMA(0, 1, At, B1); PG8_BAR; PG8_SCHED;
            PG8_LDA(At, 1, 1); PG8_STAGE(PG8_SB(1, 0), b3, voffB); PG8_STAGE(PG8_SB(1, 1), b3 + hstepB, voffB); PG8_STAGE(PG8_SA(1, 0), a3, voffA);
            PG8_WAIT_V(8); PG8_WAIT_L(0); PG8_BAR; PG8_MMA(1, 0, At, B0); PG8_MMA(1, 1, At, B1); PG8_BAR; PG8_SCHED;
        }
        if (wr == 0) PG8_BAR;
        { int fr_e = fr, fq_e = fq; asm volatile("" : "+v"(fr_e), "+v"(fq_e));
          E(acc, cur, wr, wc, fr_e, fq_e); }
        if (arr_first && ui == 0) quad_arrive(arr_first);
        if (!has_next) break;
#pragma unroll
        for (int a = 0; a < 2; ++a)
#pragma unroll
            for (int b = 0; b < 2; ++b)
#pragma unroll
                for (int m = 0; m < 4; ++m)
#pragma unroll
                    for (int n = 0; n < 2; ++n) acc[a][b][m][n] = (f32x4){0.f, 0.f, 0.f, 0.f};
        cur = nxt; cA = nA; cB = nB; ++ui;
        if (wr == 1) PG8_BAR;
    }
    PG8_WAIT_V(0);
    PG8_BAR;
#undef PG8_SA
#undef PG8_SB
#undef PG8_STAGE
#undef PG8_LDA
#undef PG8_LDB
#undef PG8_MMA
#undef PG8_WAIT_V
#undef PG8_WAIT_L
#undef PG8_BAR
#undef PG8_SCHED
}
}

struct AttnP { const bf16_t* Q; int ldq; const bf16_t* K1; int ldk1; const bf16_t* K2; int ldk2; const bf16_t* V; int ldv; bf16_t* O; int ldo; float slope2, sink2; };

__device__ __forceinline__ void lane32_swap(float& a, float& b) { asm volatile("s_nop 1\n\tv_permlane32_swap_b32 %0, %1\n\ts_nop 1" : "+v"(a), "+v"(b)); }
__device__ __forceinline__ float lane32_max(float v) { float a = v, b = v; lane32_swap(a, b); return fmaxf(a, b); }
__device__ __forceinline__ float lane32_sum(float v) { float a = v, b = v; lane32_swap(a, b); return a + b; }

template <int MODE>
__device__ __forceinline__ void attn_unit(LAS unsigned char* lds, const AttnP& P, int b, int qb, bool chain_in, bool chain_out, int& r0, int& r1, int& r2) {
    constexpr int DQK = (MODE == 2) ? 96 : 64, NKD = DQK / 16, NCH = DQK / 8, KTILE = NCH * 1024;
    constexpr int SLOT = KTILE + 8192;
    constexpr float THR = 8.f;
    int tid = threadIdx.x; asm volatile("" : "+v"(tid));
    const int lane = tid & 63, wid = __builtin_amdgcn_readfirstlane(tid >> 6), r32 = lane & 31, hi = lane >> 5;
    const int q0 = qb * 256, q0w = q0 + wid * 32;
    bf16x8 qr[NKD];
    const size_t qblk = (size_t)(8 * b + qb) * BLKE;
    { const bf16_t* qp = P.Q + qblk + (size_t)(wid * 32 + r32) * P.ldq + hi * 8;
#pragma unroll
      for (int d0 = 0; d0 < NKD; ++d0) qr[d0] = *(const bf16x8*)(qp + d0 * 16); }
    int t_lo = 0, t_hi = SEQ / 64;
    if (MODE == 0) { t_lo = 4 * qb - 2; if (t_lo < 0) t_lo = 0; t_hi = 4 * qb + 6; if (t_hi > SEQ / 64) t_hi = SEQ / 64; }
    const int NT = t_hi - t_lo;
    const bf16_t* ksrc0 = P.K1 + (size_t)(8 * b) * BLKE + (size_t)lane * P.ldk1 + wid * 8; const size_t kstr0 = (size_t)64 * P.ldk1;
    const bf16_t* ksrc1 = ksrc0; size_t kstr1 = 0;
    if (MODE == 2) { ksrc1 = P.K2 + (size_t)(8 * b) * BLKE + (size_t)lane * P.ldk2 + (wid & 3) * 8; kstr1 = (size_t)64 * P.ldk2; }
    const bf16_t* vsrc = P.V + (size_t)(8 * b) * BLKE + (size_t)(16 * (wid & 3) + (lane >> 2)) * P.ldv + (wid >> 2) * 32 + (lane & 3) * 8; const size_t vstr = (size_t)64 * P.ldv;
    const int kdst0 = wid * 1024, kdst1 = (8 + (wid & 3)) * 1024, vdst = KTILE + wid * 1024;
#define AT_DMA(t, so) do { const size_t tb_ = (size_t)((t) >> 2) * BLKE; const size_t tl_ = (size_t)((t) & 3); \
    __builtin_amdgcn_global_load_lds((const unsigned*)(ksrc0 + tb_ + tl_ * kstr0), (LAS unsigned*)(lds + (so) + kdst0), 16, 0, 0); \
    if (MODE == 2 && wid < 4) __builtin_amdgcn_global_load_lds((const unsigned*)(ksrc1 + tb_ + tl_ * kstr1), (LAS unsigned*)(lds + (so) + kdst1), 16, 0, 0); \
    __builtin_amdgcn_global_load_lds((const unsigned*)(vsrc + tb_ + tl_ * vstr), (LAS unsigned*)(lds + (so) + vdst), 16, 0, 0); } while (0)
#define AT_DMA_WAIT() asm volatile("s_waitcnt vmcnt(0)" ::: "memory")
    float m_i = (MODE == 0) ? P.sink2 : 0.f;
    float l_i = (MODE == 0 && hi == 0) ? 1.f : 0.f;
    f32x16 o0, o1, negm;
#pragma unroll
    for (int r = 0; r < 16; ++r) { o0[r] = 0.f; o1[r] = 0.f; negm[r] = -m_i; }
    const int kread = hi * 1024 + r32 * 16;
    const int vread = KTILE + (4 * hi + ((lane & 15) >> 2)) * 64 + ((lane >> 4) & 1) * 32 + (lane & 3) * 8;
    f32x16 pA0, pA1, pB0, pB1;
    bf16x8 pf00, pf01, pf10, pf11;
#define AT_SBAR() __builtin_amdgcn_sched_barrier(0)
#define AT_QKT(X0, X1, so) do { const LAS unsigned char* kb_ = lds + (so) + kread; X0 = negm; X1 = negm; \
    _Pragma("unroll") for (int d0 = 0; d0 < NKD; ++d0) { \
        const bf16x8 k0_ = *(const LAS bf16x8*)(kb_ + d0 * 2048), k1_ = *(const LAS bf16x8*)(kb_ + d0 * 2048 + 512); \
        X0 = __builtin_amdgcn_mfma_f32_32x32x16_bf16(k0_, qr[d0], X0, 0, 0, 0); X1 = __builtin_amdgcn_mfma_f32_32x32x16_bf16(k1_, qr[d0], X1, 0, 0, 0); } } while (0)
#define AT_PSM(X0, X1, t, FIRST) do { \
    if (MODE == 0) { const float fd_ = (float)(64 * (t) + 4 * hi - (q0w + r32)); \
        _Pragma("unroll") for (int r = 0; r < 16; ++r) { const float x0_ = fd_ + (float)((r & 3) + 8 * (r >> 2)), x1_ = x0_ + 32.f; \
            const float s0_ = __builtin_fmaf(-P.slope2, __builtin_fabsf(x0_), X0[r]), s1_ = __builtin_fmaf(-P.slope2, __builtin_fabsf(x1_), X1[r]); \
            X0[r] = (__builtin_fabsf(x0_) <= 128.f) ? s0_ : -1e30f; X1[r] = (__builtin_fabsf(x1_) <= 128.f) ? s1_ : -1e30f; } } \
    float mx_ = fmaxf(X0[0], X1[0]), my_ = fmaxf(X0[1], X1[1]); \
    _Pragma("unroll") for (int r = 2; r < 16; r += 2) { mx_ = fmaxf(fmaxf(mx_, X0[r]), X1[r]); my_ = fmaxf(fmaxf(my_, X0[r + 1]), X1[r + 1]); }     \
    mx_ = lane32_max(fmaxf(mx_, my_)); \
    if ((FIRST) || __any(mx_ > THR)) { \
        const float dl_ = (FIRST) ? mx_ : fmaxf(mx_, 0.f); m_i += dl_; \
        if (!(FIRST)) { const float al_ = __builtin_amdgcn_exp2f(-dl_); l_i *= al_; \
            _Pragma("unroll") for (int r = 0; r < 16; ++r) { o0[r] *= al_; o1[r] *= al_; } } \
        _Pragma("unroll") for (int r = 0; r < 16; ++r) { X0[r] -= dl_; X1[r] -= dl_; negm[r] = -m_i; } } \
    _Pragma("unroll") for (int r = 0; r < 16; ++r) X0[r] = __builtin_amdgcn_exp2f(X0[r]); } while (0)
#define AT_PKF(X, s_) __builtin_bit_cast(bf16x8, (u32x4){cvt_pk_bf16(X[8 * (s_) + 0], X[8 * (s_) + 1]), cvt_pk_bf16(X[8 * (s_) + 2], X[8 * (s_) + 3]), cvt_pk_bf16(X[8 * (s_) + 4], X[8 * (s_) + 5]), cvt_pk_bf16(X[8 * (s_) + 6], X[8 * (s_) + 7])})
#define AT_FSM(X0, X1) do { \
    _Pragma("unroll") for (int r = 0; r < 16; ++r) X1[r] = __builtin_amdgcn_exp2f(X1[r]); \
    float ls_ = X0[0];     \
    _Pragma("unroll") for (int r = 1; r < 16; ++r) ls_ += X0[r]; \
    _Pragma("unroll") for (int r = 0; r < 16; ++r) ls_ += X1[r]; \
    l_i += ls_; \
    pf00 = AT_PKF(X0, 0); pf01 = AT_PKF(X0, 1); pf10 = AT_PKF(X1, 0); pf11 = AT_PKF(X1, 1); } while (0)
#define AT_VF(vp_) ({ const s16x4 lo_ = __builtin_bit_cast(s16x4, __builtin_amdgcn_ds_read_tr16_b64_v4i16((LAS s16x4*)(vp_))); \
    const s16x4 hh_ = __builtin_bit_cast(s16x4, __builtin_amdgcn_ds_read_tr16_b64_v4i16((LAS s16x4*)((vp_) + 512))); \
    (bf16x8){lo_[0], lo_[1], lo_[2], lo_[3], hh_[0], hh_[1], hh_[2], hh_[3]}; })
#define AT_PV(so) do { const LAS unsigned char* vb_ = lds + (so) + vread; \
    o0 = __builtin_amdgcn_mfma_f32_32x32x16_bf16(AT_VF(vb_), pf00, o0, 0, 0, 0); o1 = __builtin_amdgcn_mfma_f32_32x32x16_bf16(AT_VF(vb_ + 4096), pf00, o1, 0, 0, 0); \
    o0 = __builtin_amdgcn_mfma_f32_32x32x16_bf16(AT_VF(vb_ + 1024), pf01, o0, 0, 0, 0); o1 = __builtin_amdgcn_mfma_f32_32x32x16_bf16(AT_VF(vb_ + 4096 + 1024), pf01, o1, 0, 0, 0); \
    o0 = __builtin_amdgcn_mfma_f32_32x32x16_bf16(AT_VF(vb_ + 2048), pf10, o0, 0, 0, 0); o1 = __builtin_amdgcn_mfma_f32_32x32x16_bf16(AT_VF(vb_ + 4096 + 2048), pf10, o1, 0, 0, 0); \
    o0 = __builtin_amdgcn_mfma_f32_32x32x16_bf16(AT_VF(vb_ + 3072), pf11, o0, 0, 0, 0); o1 = __builtin_amdgcn_mfma_f32_32x32x16_bf16(AT_VF(vb_ + 4096 + 3072), pf11, o1, 0, 0, 0); } while (0)
    int sl_prev = chain_in ? r0 : 0, sl_cur = chain_in ? r1 : SLOT, sl_next = chain_in ? r2 : 2 * SLOT;
#define AT_ROT() do { const int t_ = sl_prev; sl_prev = sl_cur; sl_cur = sl_next; sl_next = t_; } while (0)
#define AT_STEP(X0, X1, Y0, Y1, i) do { \
    if ((i) + 1 < NT) AT_DMA(t_lo + (i) + 1, sl_next);        \
    AT_SBAR(); AT_QKT(X0, X1, sl_cur); AT_FSM(Y0, Y1); AT_SBAR(); \
    AT_PV(sl_prev); AT_PSM(X0, X1, t_lo + (i), false); AT_SBAR(); \
    AT_DMA_WAIT(); __syncthreads(); AT_ROT(); } while (0)
    if (!chain_in) { AT_DMA(t_lo, sl_prev); AT_DMA(t_lo + 1, sl_cur); }
    AT_DMA_WAIT(); __syncthreads();
    AT_QKT(pA0, pA1, sl_prev);
    AT_PSM(pA0, pA1, t_lo, (MODE != 0));
    {
        int i = 1;
        for (; i + 1 < NT; i += 2) { AT_STEP(pB0, pB1, pA0, pA1, i); AT_STEP(pA0, pA1, pB0, pB1, i + 1); }
        AT_STEP(pB0, pB1, pA0, pA1, i);
    }
    if (chain_out) { AT_DMA(t_lo, sl_cur); AT_DMA(t_lo + 1, sl_next); r0 = sl_cur; r1 = sl_next; r2 = sl_prev; }
    AT_FSM(pB0, pB1);
    AT_PV(sl_prev);
#undef AT_DMA
#undef AT_DMA_WAIT
#undef AT_SBAR
#undef AT_QKT
#undef AT_PSM
#undef AT_PKF
#undef AT_FSM
#undef AT_VF
#undef AT_PV
#undef AT_ROT
#undef AT_STEP
    const float lt = lane32_sum(l_i);
    const float inv = 1.0f / lt;
    bf16_t* op = P.O + qblk + (size_t)(wid * 32 + r32) * P.ldo + 4 * hi;
#pragma unroll
    for (int g = 0; g < 4; ++g) {
        u32x2 w0, w1;
        w0.x = cvt_pk_bf16(o0[4 * g] * inv, o0[4 * g + 1] * inv); w0.y = cvt_pk_bf16(o0[4 * g + 2] * inv, o0[4 * g + 3] * inv);
        w1.x = cvt_pk_bf16(o1[4 * g] * inv, o1[4 * g + 1] * inv); w1.y = cvt_pk_bf16(o1[4 * g + 2] * inv, o1[4 * g + 3] * inv);
        *(u32x2*)(op + 8 * g) = w0; *(u32x2*)(op + 32 + 8 * g) = w1;
    }
    if (!chain_out) __syncthreads();
}

#define XB_TMO      128
#define XB_XCNT(j)  (256  + 64 * (j))
#define XB_XSUB(j)  (1280 + 64 * (j))
#define XB_XGEN(j)  (2304 + 64 * (j))
#define XB_TOP      3328
#define XB_TOPGEN   3392
#define XCD_BAR_WORDS 3456
#define XB_SPIN_CAP (1u << 18)
__device__ __forceinline__ unsigned xb_ld(unsigned* p)              { return __hip_atomic_load(p, __ATOMIC_RELAXED, __HIP_MEMORY_SCOPE_AGENT); }
__device__ __forceinline__ unsigned xb_add(unsigned* p, unsigned v) { return __hip_atomic_fetch_add(p, v, __ATOMIC_RELAXED, __HIP_MEMORY_SCOPE_AGENT); }
__device__ __forceinline__ unsigned xb_xcc_id() { return (unsigned)__builtin_amdgcn_s_getreg((3 << 11) | 20) & 0xFu; }
#define XB_SPIN(cond, bar) do { unsigned _sp = 0; while (cond) { __builtin_amdgcn_s_sleep(1); \
    if ((++_sp & 255u) == 0u) { if (xb_ld(&(bar)[XB_TMO])) break; if (_sp > XB_SPIN_CAP) { atomicAdd(&(bar)[XB_TMO], 1u); break; } } } } while (0)
struct XcdBarrier { unsigned* bar; unsigned x; volatile LAS unsigned* st; unsigned rank; };
__device__ __forceinline__ XcdBarrier xcd_barrier_post(unsigned* bar, volatile LAS unsigned* st) {
    XcdBarrier b; b.bar = bar; b.st = st; b.rank = 0u;
    unsigned x_ = xb_xcc_id(); asm volatile("" : "+s"(x_)); b.x = x_;
    if (threadIdx.x == 0) b.rank = xb_add(&bar[XB_XCNT(b.x)], 1u);
    return b;
}
__device__ __forceinline__ void xcd_barrier_complete(unsigned* bar, unsigned x, unsigned& nloc, unsigned& nx) {
    const unsigned G = gridDim.x * gridDim.y * gridDim.z;
    unsigned sum, cnt, mine, sp = 0u;
    for (;;) {
        sum = 0u; cnt = 0u; mine = 0u;
#pragma unroll
        for (unsigned j = 0; j < 16; ++j) { const unsigned c = xb_ld(&bar[XB_XCNT(j)]); sum += c; cnt += (c > 0u) ? 1u : 0u; mine = (j == x) ? c : mine; }
        if (sum == G) break;
        __builtin_amdgcn_s_sleep(1);
        if ((++sp & 255u) == 0u) { if (xb_ld(&bar[XB_TMO])) break; if (sp > XB_SPIN_CAP) { atomicAdd(&bar[XB_TMO], 1u); break; } }
    }
    nloc = mine > 0u ? mine : 1u; nx = cnt > 0u ? cnt : 1u;
}
__device__ __forceinline__ void xcd_barrier(const XcdBarrier& b) {
    asm volatile("s_waitcnt vmcnt(0)" ::: "memory");
    __syncthreads();
    if (threadIdx.x == 0) {
        unsigned* bar = b.bar; asm volatile("" : "+s"(bar));
        __builtin_amdgcn_s_waitcnt(0);
        unsigned nloc = b.st[0], nx = b.st[1];
        if (nloc == 0u) { xcd_barrier_complete(bar, b.x, nloc, nx); b.st[0] = nloc; b.st[1] = nx; }
        const unsigned old = xb_add(&bar[XB_XSUB(b.x)], 1u);
        const unsigned gen = old / nloc;
        if (old + 1u == (gen + 1u) * nloc) {
            __builtin_amdgcn_fence(__ATOMIC_RELEASE, "agent");
            asm volatile("s_waitcnt vmcnt(0)" ::: "memory");
            const unsigned og = xb_add(&bar[XB_TOP], 1u);
            const unsigned tg = og / nx;
            if (og + 1u == (tg + 1u) * nx) xb_add(&bar[XB_TOPGEN], 1u);
            else XB_SPIN(xb_ld(&bar[XB_TOPGEN]) == tg, bar);
            __builtin_amdgcn_fence(__ATOMIC_ACQUIRE, "agent");
            xb_add(&bar[XB_XGEN(b.x)], 1u);
            asm volatile("s_waitcnt vmcnt(0)" ::: "memory");
        } else {
            XB_SPIN(xb_ld(&bar[XB_XGEN(b.x)]) == gen, bar);
            __builtin_amdgcn_fence(__ATOMIC_ACQUIRE, "agent");
            asm volatile("s_waitcnt vmcnt(0)" ::: "memory");
        }
    }
    __syncthreads();
}

__device__ __forceinline__ void local_barrier(unsigned* arr, unsigned* gen_w, unsigned* tmo, unsigned nloc) {
    asm volatile("s_waitcnt vmcnt(0)" ::: "memory");
    __syncthreads();
    if (threadIdx.x == 0) {
        __builtin_amdgcn_s_waitcnt(0);
        const unsigned old = xb_add(arr, 1u);
        const unsigned gen = old / nloc;
        if (old + 1u == (gen + 1u) * nloc) xb_add(gen_w, 1u);
        else { unsigned sp_ = 0; while (xb_ld(gen_w) == gen) { __builtin_amdgcn_s_sleep(1); if ((++sp_ & 255u) == 0u) { if (xb_ld(tmo)) break; if (sp_ > XB_SPIN_CAP) { atomicAdd(tmo, 1u); break; } } } }
        __builtin_amdgcn_fence(__ATOMIC_ACQUIRE, "agent");
        asm volatile("s_waitcnt vmcnt(0)" ::: "memory");
    }
    __syncthreads();
}

__device__ __forceinline__ void quad_arrive(unsigned* arr) {
    asm volatile("s_waitcnt vmcnt(0)" ::: "memory");
    __syncthreads();
    if (threadIdx.x == 0) (void)__hip_atomic_fetch_add(arr, 1u, __ATOMIC_RELAXED, __HIP_MEMORY_SCOPE_AGENT);
}
__device__ __forceinline__ void quad_wait(unsigned* arr, unsigned expect, unsigned* tmo) {
    if (threadIdx.x == 0) {
        unsigned sp_ = 0;
        while (xb_ld(arr) < expect) { __builtin_amdgcn_s_sleep(1); if ((++sp_ & 255u) == 0u) { if (xb_ld(tmo)) break; if (sp_ > XB_SPIN_CAP) { atomicAdd(tmo, 1u); break; } } }
        __builtin_amdgcn_fence(__ATOMIC_ACQUIRE, "agent");
        asm volatile("s_waitcnt vmcnt(0)" ::: "memory");
    }
    __syncthreads();
}

struct EpiResFinal {
    static constexpr int BMAP = 1;
    const float* base; float* out; float* ssn; const float* gain; int ldc;
    bool fast; unsigned* qarr; unsigned qexpect; unsigned* tmo; XcdBarrier xbar;
    __device__ __forceinline__ void operator()(f32x4 (&acc)[2][2][4][2], const pg8::Unit& u, int wr, int wc, int fr, int fq) const {
        const int row0 = u.pm * pg8::BM + wr * 64 + fr; const int col0 = u.pn * pg8::BM + wc * 32 + 8 * fq;
#pragma unroll
        for (int ai = 0; ai < 2; ++ai)
#pragma unroll
            for (int m = 0; m < 4; ++m) { const int row = row0 + ai * pg8::HALF + m * 16; const size_t off = (size_t)row * ldc + col0; float sq = 0.f;
#pragma unroll
                for (int bj = 0; bj < 2; ++bj) { const f32x4 b0 = *(const f32x4*)(base + off + bj * pg8::HALF), b1 = *(const f32x4*)(base + off + bj * pg8::HALF + 4);
                    const f32x4 o0 = b0 + acc[ai][bj][m][0], o1 = b1 + acc[ai][bj][m][1];
                    acc[ai][bj][m][0] = o0; acc[ai][bj][m][1] = o1;
                    sq += ((o0[0] * o0[0] + o0[1] * o0[1]) + (o0[2] * o0[2] + o0[3] * o0[3])) + ((o1[0] * o1[0] + o1[1] * o1[1]) + (o1[2] * o1[2] + o1[3] * o1[3])); }
                sq += __shfl_xor(sq, 16); sq += __shfl_xor(sq, 32);
                if (fq == 0) ssn[(size_t)row * 16 + u.pn * 4 + wc] = sq;
                if (m & 1) asm volatile("" ::: "memory"); }
        if (fast) { quad_arrive(qarr); quad_wait(qarr, qexpect, tmo); } else xcd_barrier(xbar);
        f32x4 g[2][2];
#pragma unroll
        for (int bj = 0; bj < 2; ++bj) { g[bj][0] = *(const f32x4*)(gain + col0 + bj * pg8::HALF); g[bj][1] = *(const f32x4*)(gain + col0 + bj * pg8::HALF + 4); }
#pragma unroll
        for (int ai = 0; ai < 2; ++ai)
#pragma unroll
            for (int m = 0; m < 4; ++m) { const int row = row0 + ai * pg8::HALF + m * 16; const size_t off = (size_t)row * ldc + col0;
                const float rs = rsqrtf(ss_sum<16>(ssn + (size_t)row * 16) * (1.f / DM) + EPS);
#pragma unroll
                for (int bj = 0; bj < 2; ++bj) { *(f32x4*)(out + off + bj * pg8::HALF) = acc[ai][bj][m][0] * rs * g[bj][0]; *(f32x4*)(out + off + bj * pg8::HALF + 4) = acc[ai][bj][m][1] * rs * g[bj][1]; }
                if (m & 1) asm volatile("" ::: "memory"); }
    }
};

constexpr int NWAVES = 8, NTHREADS = 512;
constexpr int LDS_BYTES = 147456;
constexpr int LDS_MISC = 131072;

struct Args { const float* in[15]; float* out; unsigned char* ws; int never, pad; };

__device__ __forceinline__ float wave_sum(float v) {
#pragma unroll
    for (int o = 1; o < 64; o <<= 1) v += __shfl_xor(v, o);
    return v;
}
struct WItem { const float* W; const float* gain; bf16_t* WT; int N, ldk, k0, n0; };
__device__ __forceinline__ WItem witem(int N, int ldk, const float* W, const float* gain, bf16_t* WT, int item) {
    WItem d; const int nblk = N / 32; d.W = W; d.gain = gain; d.WT = WT; d.N = N; d.ldk = ldk; d.k0 = 64 * (item / nblk); d.n0 = 32 * (item % nblk); return d;
}
#define WI_LOAD(v, gv, d) do { const float* wp_ = (d).W + (size_t)((d).k0 + (lane >> 5)) * (d).N + (d).n0 + (lane & 31); \
    _Pragma("unroll") for (int i = 0; i < 32; ++i) v[i] = __builtin_nontemporal_load(wp_ + (size_t)(2 * i) * (d).N);     \
    gv = (d).gain ? (d).gain[(d).k0 + lane] : 1.f; } while (0)
#define WI_PROC(v, gv, d) do { \
    _Pragma("unroll") for (int i = 0; i < 32; ++i) { const float g0_ = __builtin_bit_cast(float, __builtin_amdgcn_readlane(__builtin_bit_cast(int, gv), 2 * i)), g1_ = __builtin_bit_cast(float, __builtin_amdgcn_readlane(__builtin_bit_cast(int, gv), 2 * i + 1)); \
        scr[(2 * i + (lane >> 5)) * 33 + (lane & 31)] = v[i] * ((lane >> 5) ? g1_ : g0_); } \
    asm volatile("s_waitcnt lgkmcnt(0)" ::: "memory"); \
    { const int c_ = lane & 7; \
      _Pragma("unroll") for (int j = 0; j < 4; ++j) { const int n_ = (lane >> 3) + 8 * j; const LAS float* sp_ = scr + (8 * c_) * 33 + n_; \
        u32x4 o_; o_.x = pk2(sp_[0 * 33], sp_[1 * 33]); o_.y = pk2(sp_[2 * 33], sp_[3 * 33]); o_.z = pk2(sp_[4 * 33], sp_[5 * 33]); o_.w = pk2(sp_[6 * 33], sp_[7 * 33]); \
        *(u32x4*)((d).WT + (size_t)((d).n0 + n_) * (d).ldk + (d).k0 + 8 * c_) = o_; } } \
    asm volatile("s_waitcnt lgkmcnt(0)" ::: "memory"); } while (0)

__device__ __forceinline__ void row_to_bf16_ss(const float* xrow, bf16_t* orow, float* ssp, int lane) {
    const f32x4* xr = (const f32x4*)xrow + lane;
    f32x4 v[4]; float sq = 0.f;
#pragma unroll
    for (int j = 0; j < 4; ++j) { v[j] = __builtin_nontemporal_load(xr + 64 * j); sq += (v[j].x * v[j].x + v[j].y * v[j].y) + (v[j].z * v[j].z + v[j].w * v[j].w); }
    sq = wave_sum(sq);
    u32x2* o8 = (u32x2*)orow + lane;
#pragma unroll
    for (int j = 0; j < 4; ++j) { u32x2 w; w.x = cvt_pk_bf16(v[j].x, v[j].y); w.y = cvt_pk_bf16(v[j].z, v[j].w); o8[64 * j] = w; }
    if (lane < 16) ssp[lane] = (lane == 0) ? sq : 0.f;
}
__device__ __forceinline__ void final_row(float* xrow, const float* gain, float ssv, int lane) {
    f32x4* xr = (f32x4*)xrow + lane; const f32x4* gr = (const f32x4*)gain + lane;
    const float rstd = rsqrtf(ssv * (1.f / DM) + EPS);
#pragma unroll
    for (int j = 0; j < 4; ++j) { const f32x4 g = gr[64 * j]; xr[64 * j] = xr[64 * j] * rstd * g; }
}

__global__ void __launch_bounds__(NTHREADS, 2) fwd_kernel(Args args) {
    extern __shared__ __attribute__((aligned(16))) unsigned char lds_raw[];
    LAS unsigned char* lds = (LAS unsigned char*)lds_raw;
    cg::grid_group grid = cg::this_grid();
    const int wave = __builtin_amdgcn_readfirstlane((int)threadIdx.x >> 6);
    const int G = gridDim.x, bx = blockIdx.x;
    const int gw = bx * NWAVES + wave, NGW = G * NWAVES;
    unsigned* ctl0 = (unsigned*)(args.ws + WS_CTL);
    if (args.never != 0) grid.sync();
    { volatile LAS unsigned* st = (volatile LAS unsigned*)(lds + LDS_MISC + 64); if (threadIdx.x < 2) st[threadIdx.x] = 0u; }
    __syncthreads();
    XcdBarrier xbar = xcd_barrier_post(ctl0 + CW_BAR, (volatile LAS unsigned*)(lds + LDS_MISC + 64));
typedef const Args __attribute__((address_space(4))) KArgs;
#define PH_BEGIN { int tid = threadIdx.x; asm volatile("" : "+v"(tid)); const int lane = tid & 63; (void)lane; \
    KArgs* ap_ = (KArgs*)__builtin_amdgcn_kernarg_segment_ptr(); asm volatile("" : "+s"(ap_)); \
    unsigned char* ws = ap_->ws; float* out = ap_->out; (void)out; \
    const float* x_in = ap_->in[0]; const float* attn_norm = ap_->in[1]; const float* w_in = ap_->in[2]; const float* a_sink = ap_->in[3]; \
    const float* b_q_norm = ap_->in[4]; const float* b_k_norm = ap_->in[5]; const float* c_q_norm = ap_->in[6]; const float* c_kv_norm = ap_->in[7]; \
    const float* w_uq = ap_->in[8]; const float* w_ukv = ap_->in[9]; const float* w_out = ap_->in[10]; const float* mlp_norm = ap_->in[11]; \
    const float* w_ff1 = ap_->in[12]; const float* w_ff2 = ap_->in[13]; const float* final_norm = ap_->in[14]; \
    (void)x_in; (void)attn_norm; (void)w_in; (void)a_sink; (void)b_q_norm; (void)b_k_norm; (void)c_q_norm; (void)c_kv_norm; (void)w_uq; (void)w_ukv; (void)w_out; (void)mlp_norm; (void)w_ff1; (void)w_ff2; (void)final_norm; \
    unsigned* ctl = (unsigned*)(ws + WS_CTL); f32x2* rope = (f32x2*)(ws + WS_ROPE); (void)ctl; (void)rope; \
    float* SSA = (float*)(ws + WS_SSA); float* SSM = (float*)(ws + WS_SSM); float* SSCQ = (float*)(ws + WS_SSCQ); float* SSCKV = (float*)(ws + WS_SSCKV); (void)SSA; (void)SSM; (void)SSCQ; (void)SSCKV; \
    bf16_t* XN = (bf16_t*)(ws + WS_XN); bf16_t* U = (bf16_t*)(ws + WS_U); bf16_t* Pb = (bf16_t*)(ws + WS_U + SUB_P); (void)XN; (void)U; (void)Pb; \
    bf16_t* CQ = (bf16_t*)(ws + WS_U + SUB_CQ); bf16_t* CKV = (bf16_t*)(ws + WS_U + SUB_CKV); bf16_t* MIX = (bf16_t*)(ws + WS_U + SUB_MIX); (void)CQ; (void)CKV; (void)MIX;
#define PH_END_GRID xcd_barrier(xbar); }
#define PH_END_GROUP if (fast) local_barrier(ctl + CW_BAR2 + XB_XSUB(xbar.x), ctl + CW_BAR2 + XB_XGEN(xbar.x), ctl + CW_BAR2 + XB_TMO, 32u); else xcd_barrier(xbar); }
#define PH_END_QUAD if (fast) local_barrier(ctl + CW_BAR3 + 128 * (8 * grp + (rk & 7)), ctl + CW_BAR3 + 128 * (8 * grp + (rk & 7)) + 64, ctl + CW_BAR2 + XB_TMO, 4u); else xcd_barrier(xbar); }

    PH_BEGIN
    {
        LAS float* scr = (LAS float*)(lds + wave * 16384);
        constexpr int I_IN = 16 * 53, I_UQ = 4 * 12, I_UKV = 2 * 16, I_OUT = 16 * 32, I_F1 = 16 * 128, I_F2 = 64 * 32;
        constexpr int PER_L = I_IN + I_UQ + I_UKV + I_OUT + I_F1 + I_F2;
#define WI_DECODE(it_, d_) do { const int l_ = (it_) / PER_L; int r_ = (it_) % PER_L; unsigned char* wl_ = ws + WS_W + (size_t)l_ * W_LAYER; \
            if (r_ < I_IN) d_ = witem(IN_COLS, DM, w_in + (size_t)l_ * DM * IN_COLS, attn_norm + l_ * DM, (bf16_t*)(wl_ + WO_IN), r_); \
            else if ((r_ -= I_IN) < I_UQ) d_ = witem(384, 256, w_uq + (size_t)l_ * 256 * 384, c_q_norm + l_ * 256, (bf16_t*)(wl_ + WO_UQ), r_); \
            else if ((r_ -= I_UQ) < I_UKV) d_ = witem(512, 128, w_ukv + (size_t)l_ * 128 * 512, c_kv_norm + l_ * 128, (bf16_t*)(wl_ + WO_UKV), r_); \
            else if ((r_ -= I_UKV) < I_OUT) d_ = witem(DM, DM, w_out + (size_t)l_ * DM * DM, nullptr, (bf16_t*)(wl_ + WO_OUT), r_); \
            else if ((r_ -= I_OUT) < I_F1) d_ = witem(FF, DM, w_ff1 + (size_t)l_ * DM * FF, mlp_norm + l_ * DM, (bf16_t*)(wl_ + WO_FF1), r_); \
            else d_ = witem(DM, FF, w_ff2 + (size_t)l_ * FF * DM, nullptr, (bf16_t*)(wl_ + WO_FF2), r_ - I_F1); } while (0)
        int odd_ = wave & 1, two_ = 2; asm volatile("" : "+s"(odd_), "+s"(two_));
        for (int ph_ = 0; ph_ < two_; ++ph_) {
        if (ph_ != odd_) { for (int m = gw; m < M; m += NGW) row_to_bf16_ss(x_in + (size_t)m * DM, XN + (size_t)m * DM, SSA + (size_t)m * 16, lane); }
        else {
            constexpr int TOT = DEPTH * PER_L;
            float va[32], vb[32], ga = 1.f, gb = 1.f; WItem da, db;
            int it = gw;
            if (it < TOT) { WI_DECODE(it, da); WI_LOAD(va, ga, da); }
            while (it < TOT) {
                const int itn = it + NGW; const bool hn = itn < TOT;
                if (hn) { WI_DECODE(itn, db); WI_LOAD(vb, gb, db); }
                WI_PROC(va, ga, da);
                if (!hn) break;
                it = itn; da = db; ga = gb;
#pragma unroll
                for (int i = 0; i < 32; ++i) va[i] = vb[i];
            }
        }
        }
#undef WI_DECODE
        {
            constexpr int Z_IN = 96 * 1024 / 8, Z_UQ = 128 * 256 / 8, Z_L = Z_IN + Z_UQ;
            const int gt = bx * NTHREADS + tid, NGT = G * NTHREADS;
            for (int it = gt; it < DEPTH * Z_L; it += NGT) {
                const int l = it / Z_L; int r = it % Z_L; unsigned char* wl = ws + WS_W + (size_t)l * W_LAYER;
                u32x4* dst;
                if (r < Z_IN) dst = (u32x4*)(wl + WO_IN + (size_t)IN_COLS * DM * 2) + r;
                else dst = (u32x4*)(wl + WO_UQ + (size_t)384 * 256 * 2) + (r - Z_IN);
                *dst = (u32x4){0u, 0u, 0u, 0u};
            }
            for (int it = gt; it < 2048 * 16; it += NGT) {
                const int p = it >> 4, j = it & 15;
                const float inv = (float)exp(-(double)j * (9.210340371976184 / 16.0));
                const float ang = (float)p * inv;
                double rev = (double)ang * 0.15915494309189535; rev -= floor(rev);
                const float rf = (float)rev;
                rope[it] = (f32x2){__builtin_amdgcn_cosf(rf), __builtin_amdgcn_sinf(rf)};
            }
        }
        __syncthreads();
    }
    PH_END_GRID

    {
        volatile LAS unsigned* gi = (volatile LAS unsigned*)(lds + LDS_MISC + 128);
        if (threadIdx.x == 0) {
            unsigned* bar = ctl0 + CW_BAR; unsigned npop = 0u, below = 0u; bool all32 = true;
            for (unsigned j = 0; j < 16; ++j) { const unsigned c = xb_ld(&bar[XB_XCNT(j)]); if (c) { ++npop; if (j < xbar.x) ++below; if (c != 32u) all32 = false; } }
            const bool f = (G == 256) && (npop == 8u) && all32 && (xb_ld(&bar[XB_TMO]) == 0u);
            const int gsz = 32;
            gi[0] = f ? 1u : 0u; gi[1] = f ? below : (unsigned)(bx / gsz); gi[2] = f ? xbar.rank : (unsigned)(bx % gsz); gi[3] = (unsigned)gsz; gi[4] = (unsigned)(G / gsz);
        }
        __syncthreads();
    }
    const volatile LAS unsigned* gi_ = (const volatile LAS unsigned*)(lds + LDS_MISC + 128);
    const bool fast = __builtin_amdgcn_readfirstlane(gi_[0]) != 0u;
    const int grp = __builtin_amdgcn_readfirstlane(gi_[1]), rk = __builtin_amdgcn_readfirstlane(gi_[2]), gsize = __builtin_amdgcn_readfirstlane(gi_[3]), ngroups = __builtin_amdgcn_readfirstlane(gi_[4]);

    int nsteps = 6 * DEPTH; asm volatile("" : "+s"(nsteps));
    unsigned qn = 0u;
    for (int step = 0; step < nsteps; ++step) {
        const int l = step / 6, kind = step % 6;
        PH_BEGIN
        const unsigned char* wl = ws + WS_W + (size_t)l * W_LAYER;
        for (int b = grp; b < BATCH; b += ngroups) {
            if (kind <= 1) {
                if (kind == 0) {
                    pg8::Gemm g{XN, (const bf16_t*)(wl + WO_IN), M, PLD, DM, DM, (size_t)256 * DM * 2}; pg8::G1Order S{rk, 8 * b};
                    LAS float* rsl = (LAS float*)(lds + LDS_MISC + 1024);
                    pg8::EpiG1 E{Pb, rsl, SSCQ, SSCKV, b_q_norm + l * 64, b_k_norm + l * 64, rope};
                    pg8::gemm_phase(lds, g, S, E, SSA + (size_t)(8 * b + (rk & 7)) * 256 * 16, rsl, (fast && rk < 24) ? (ctl + CW_BAR3 + 128 * (8 * grp + (rk & 7))) : nullptr);
                    if (fast && rk < 24) quad_arrive(ctl + CW_GP + 64 * xbar.x);
                }
                else if (fast && rk >= 24) quad_arrive(ctl + CW_GP + 64 * xbar.x);
                if (kind == 1) {
                    const int sub = rk >> 3;
                    if (fast && sub != 2) quad_wait(ctl + CW_BAR3 + 128 * (8 * grp + (rk & 7)), 4u * qn, ctl + CW_BAR2 + XB_TMO);
                    if (sub == 3) { pg8::PairOrder S{8 * b + (rk & 7), 0, 2};
                        pg8::Gemm g{Pb + C_Q0, (const bf16_t*)(wl + WO_UQ), M, 512, 256, PLD, BLK}; pg8::EpiRope E{CQ, CQ_LD, rope, SSCQ}; pg8::gemm_phase(lds, g, S, E); }
                    else if (sub < 2) { pg8::PairOrder S{8 * b + (rk & 7), sub, 1};
                        pg8::Gemm g{Pb + C_KV0, (const bf16_t*)(wl + WO_UKV), M, 512, 128, PLD, BLK}; pg8::EpiBf16<0, 2> E{CKV, CKV_LD, SSCKV, 1.f / 128.f, nullptr}; pg8::gemm_phase(lds, g, S, E); }
                }
            } else if (kind == 2) {
                LAS unsigned* slot = (LAS unsigned*)(lds + LDS_MISC);
                int r0 = 0, r1 = 0, r2 = 0; bool ch_in = false;
                for (int j = 0; ; ++j) {
                    unsigned u; bool ch_out = false;
                    if (rk < 16 && j < 2) { u = 2u * rk + j; ch_out = (j == 0); }
                    else if (rk >= 16 && j < 3) { u = 32u + 3u * (rk - 16) + j;
                        ch_out = (j < 2) && ((((u - 32u) >> 3) / 3u) == (((u + 1u - 32u) >> 3) / 3u)); }
                    else {
                        if (tid == 0) *slot = atomicAdd(ctl + CW_Q + 64 * (8 * l + b), 1u);
                        __syncthreads();
                        u = 80u + *slot;
                        __syncthreads();
                        if (u >= 128u) break;
                    }
                    if (u < 32u) {
                        const int h = u >> 3, qb = u & 7;
                        AttnP P{CQ + h * 96, CQ_LD, CKV + h * 128, CKV_LD, Pb + C_R0, PLD, CKV + h * 128 + 64, CKV_LD, MIX + 768 + h * 64, DM, 0.f, 0.f};
                        attn_unit<2>(lds, P, b, qb, ch_in, ch_out, r0, r1, r2); ch_in = ch_out;
                    } else if (u < 80u) {
                        const int v = u - 32, h = v >> 3, qb = v & 7;
                        AttnP P{Pb + B_Q0 + h * 64, PLD, Pb + B_K0 + (h / 3) * 64, PLD, nullptr, 0, Pb + B_V0 + (h / 3) * 64, PLD, MIX + 384 + h * 64, DM, 0.f, 0.f};
                        attn_unit<1>(lds, P, b, qb, ch_in, ch_out, r0, r1, r2); ch_in = ch_out;
                    } else {
                        const int v = u - 80; int h, qb; if (v < 36) { h = v / 6; qb = 1 + v % 6; } else { h = (v - 36) >> 1; qb = ((v - 36) & 1) * 7; }
                        const float slope = exp2f(-8.0f * (float)(h + 1) / 6.0f);
                        AttnP P{Pb + A_Q0 + h * 64, PLD, Pb + A_K0 + (h / 3) * 64, PLD, nullptr, 0, Pb + A_V0 + (h / 3) * 64, PLD, MIX + h * 64, DM, slope * LOG2E, a_sink[l * 6 + h] * LOG2E};
                        attn_unit<0>(lds, P, b, qb, false, false, r0, r1, r2); ch_in = false;
                    }
                }
            } else if (kind == 5 && l == DEPTH - 1) {
                pg8::Gemm g{U, (const bf16_t*)(wl + WO_FF2), M, DM, FF, FF, BLK}; pg8::GroupOrder S; S.init(DM, b, rk, gsize);
                unsigned* qw = ctl + CW_BAR3 + 128 * (8 * grp + (rk & 7));
                EpiResFinal E{out, out, SSA, final_norm, DM, fast, qw, 4u * (qn + 1u), ctl + CW_BAR2 + XB_TMO, xbar}; pg8::gemm_phase(lds, g, S, E);
            } else if (kind == 3 || kind == 5) {
                const bool g3 = (kind == 3);
                pg8::Gemm g{g3 ? MIX : U, (const bf16_t*)(wl + (g3 ? WO_OUT : WO_FF2)), M, DM, g3 ? DM : FF, g3 ? DM : FF, BLK}; pg8::GroupOrder S; S.init(DM, b, rk, gsize);
                pg8::EpiRes E{(g3 && l == 0) ? x_in : (const float*)out, out, XN, g3 ? SSM : SSA, DM, g3 && l == 0}; pg8::gemm_phase(lds, g, S, E);
            } else if (kind == 4) {
                pg8::Gemm g{XN, (const bf16_t*)(wl + WO_FF1), M, FF, DM, DM, (size_t)256 * DM * 2}; pg8::GroupOrder S; S.init(FF, b, rk, gsize);
                LAS float* rsl = (LAS float*)(lds + LDS_MISC + 1024);
                pg8::EpiBf16<2, 0> E{U, FF, nullptr, 0.f, rsl}; pg8::gemm_phase(lds, g, S, E, SSM + (size_t)(8 * b + (rk & 7)) * 256 * 16, rsl);
            }
        }
        if (step + 1 < nsteps) {
            if (!fast) xcd_barrier(xbar);
            else if (kind == 1) {
                quad_arrive(ctl + CW_GA + 64 * xbar.x);
                if (rk >= 16) quad_wait(ctl + CW_GP + 64 * xbar.x, 32u * (unsigned)(l + 1), ctl + CW_BAR2 + XB_TMO);
                else quad_wait(ctl + CW_GA + 64 * xbar.x, 32u * (unsigned)(l + 1), ctl + CW_BAR2 + XB_TMO);
            }
            else if (kind == 2) local_barrier(ctl + CW_BAR2 + XB_XSUB(xbar.x), ctl + CW_BAR2 + XB_XGEN(xbar.x), ctl + CW_BAR2 + XB_TMO, 32u);
            else { unsigned* qw_ = ctl + CW_BAR3 + 128 * (8 * grp + (rk & 7));
                if (kind == 0) { if (rk >= 24) quad_arrive(qw_); ++qn; }
                else { quad_arrive(qw_); ++qn; quad_wait(qw_, 4u * qn, ctl + CW_BAR2 + XB_TMO); } }
        }
        }
    }
#undef PH_BEGIN
#undef PH_END_GROUP
#undef PH_END_QUAD
#undef PH_END_GRID
}


extern "C" void kernel_launch(void* const* d_in, const int* in_sizes, int n_in, void* d_out, int out_size, void* d_ws, size_t ws_size, hipStream_t stream) {
    static int grid = 0;
    if (grid == 0) {
        int dev = 0, cus = 0, per_cu = 0;
        hipGetDevice(&dev);
        hipDeviceGetAttribute(&cus, hipDeviceAttributeMultiprocessorCount, dev);
        if (hipFuncSetAttribute((const void*)fwd_kernel, hipFuncAttributeMaxDynamicSharedMemorySize, LDS_BYTES) != hipSuccess) { fprintf(stderr, "hipFuncSetAttribute failed\n"); }
        hipOccupancyMaxActiveBlocksPerMultiprocessor(&per_cu, (const void*)fwd_kernel, NTHREADS, LDS_BYTES);
        if (per_cu < 1) { fprintf(stderr, "occupancy query says %d\n", per_cu); per_cu = 1; }
        (void)hipGetLastError();
        grid = cus * 1;
        if (grid % 32 != 0) { fprintf(stderr, "this kernel needs a multiple of 32 workgroups (got %d)\n", grid); grid = -1; }
        if (grid > 0 && ws_size < WS_END) { fprintf(stderr, "workspace too small: %zu < %zu\n", ws_size, (size_t)WS_END); grid = -1; }
    }
    if (grid < 0) return;
    hipMemsetAsync((char*)d_ws + WS_CTL, 0, CTL_BYTES, stream);
    Args a{};
    for (int i = 0; i < 15; ++i) a.in[i] = (const float*)d_in[i];
    a.out = (float*)d_out; a.ws = (unsigned char*)d_ws;
    a.never = 0; a.pad = 0;
    void* kargs[] = {&a};
    hipError_t e = hipLaunchCooperativeKernel((const void*)fwd_kernel, dim3(grid), dim3(NTHREADS), kargs, LDS_BYTES, stream);
    if (e != hipSuccess) fprintf(stderr, "cooperative launch failed: %s (grid %d)\n", hipGetErrorString(e), grid);
}
```

```cpp
#include <hip/hip_runtime.h>
#include <hip/hip_cooperative_groups.h>
#include <cstdio>
#include <cstdint>
namespace cg = cooperative_groups;

#define LAS __attribute__((address_space(3)))
typedef unsigned short bf16_t;
typedef short bf16x8 __attribute__((ext_vector_type(8)));
typedef short s16x4 __attribute__((ext_vector_type(4)));
typedef float f32x4 __attribute__((ext_vector_type(4)));
typedef float f32x2 __attribute__((ext_vector_type(2)));
typedef float f32x16 __attribute__((ext_vector_type(16)));
typedef unsigned u32x4 __attribute__((ext_vector_type(4)));
typedef unsigned u32x2 __attribute__((ext_vector_type(2)));

constexpr int BATCH = 8, SEQ = 2048, DM = 1024, DEPTH = 4, FF = 4096;
constexpr int M = BATCH * SEQ;
constexpr int IN_COLS = 1696, PLD = 1792;
constexpr int CQ_LD = 512, CKV_LD = 512;
constexpr float EPS = 1e-6f;
constexpr float LOG2E = 1.4426950408889634f;
constexpr int A_Q0 = 0, A_K0 = 384, A_V0 = 512, B_Q0 = 640, B_K0 = 1024, B_V0 = 1152, C_Q0 = 1280, C_KV0 = 1536, C_R0 = 1664;

constexpr size_t MiB = 1u << 20;
constexpr size_t WS_CTL = 0, CTL_BYTES = 131072;
constexpr int CW_BAR = 4096, CW_BAR2 = 8192, CW_BAR3 = 12288;
constexpr int CW_GP = 24576, CW_GA = 25600;
constexpr int CW_Q = 64;
constexpr size_t WS_ROPE = 1 * MiB;
constexpr size_t WS_SSA = 1 * MiB + 256 * 1024, WS_SSM = WS_SSA + (size_t)M * 16 * 4, WS_SSCQ = WS_SSM + (size_t)M * 16 * 4, WS_SSCKV = WS_SSCQ + (size_t)M * 4 * 4, WS_SS_END = WS_SSCKV + (size_t)M * 2 * 4;
constexpr size_t WS_W = 4 * MiB, W_LAYER = 22 * MiB;
constexpr size_t WO_IN = 0, WO_UQ = WO_IN + (size_t)PLD * DM * 2, WO_UKV = WO_UQ + 512 * 256 * 2, WO_OUT = WO_UKV + 512 * 256 * 2,
                 WO_FF1 = WO_OUT + (size_t)DM * DM * 2, WO_FF2 = WO_FF1 + (size_t)FF * DM * 2, WO_END = WO_FF2 + (size_t)FF * DM * 2;
static_assert(WO_END <= W_LAYER, "weights per layer");
static_assert(WS_SS_END <= WS_W, "ss arrays");
constexpr size_t WS_XN = WS_W + DEPTH * W_LAYER;
constexpr size_t WS_U = WS_XN + (size_t)M * DM * 2;
constexpr size_t BLK = 2 * MiB, BLKE = BLK / 2;
constexpr size_t SUB_P = 0, SUB_CQ = SUB_P + 256 * (size_t)PLD * 2, SUB_CKV = SUB_CQ + 256 * (size_t)CQ_LD * 2, SUB_MIX = SUB_CKV + 256 * (size_t)CKV_LD * 2;
static_assert(SUB_MIX + 256 * (size_t)DM * 2 <= BLK && 256 * (size_t)FF * 2 == BLK, "row-block overlay");
constexpr size_t WS_END = WS_U + (size_t)M * FF * 2;
static_assert(WS_END <= 256 * MiB, "d_ws map");

typedef __bf16 bf16x2_t __attribute__((ext_vector_type(2)));
__device__ __forceinline__ unsigned cvt_pk_bf16(float lo, float hi) { const f32x2 v = {lo, hi}; const bf16x2_t b = __builtin_convertvector(v, bf16x2_t); return __builtin_bit_cast(unsigned, b); }
__device__ __forceinline__ unsigned f2bf(float f) { unsigned u = __builtin_bit_cast(unsigned, f); return (u + 0x7fffu + ((u >> 16) & 1u)) >> 16; }
__device__ __forceinline__ unsigned pk2(float lo, float hi) { return f2bf(lo) | (f2bf(hi) << 16); }
__device__ __forceinline__ float bf2f(unsigned b) { return __builtin_bit_cast(float, b << 16); }

template <int NP> __device__ __forceinline__ float ss_sum(const float* p) {
    if constexpr (NP == 2) { const f32x2 a = *(const f32x2*)p; return a.x + a.y; }
    else { float t = 0.f;
#pragma unroll
        for (int j = 0; j < NP / 4; ++j) { const f32x4 a = *(const f32x4*)(p + 4 * j); t += (a.x + a.y) + (a.z + a.w); }
        return t; }
}
__device__ __forceinline__ void quad_arrive(unsigned* arr);
namespace pg8 {
constexpr int BM = 256, BK = 64, HALF = 128, HTB = HALF * BK * 2, STAGE_BYTES = 8 * HTB, NXCD = 8, WGM = 8;
__host__ __device__ __forceinline__ int lds_byte(int r, int c) { const int st = (r >> 4) * 2 + (c >> 5), rr = r & 15, cc = c & 31, ob = rr * 64 + cc * 2; return st * 1024 + (ob ^ (((ob >> 9) & 1) << 5)); }
__host__ __device__ __forceinline__ void stage_rc(int b, int& R, int& C) { const int st = b / 1024, sb = b % 1024, swz = sb ^ (((sb >> 9) & 1) << 5); R = (st >> 1) * 16 + swz / 64; C = (st & 1) * 32 + (swz % 64) / 2; }
__host__ __device__ __forceinline__ int perm32(int rho) { const int n = rho >> 4, i = rho & 15; return 8 * (i >> 2) + 4 * n + (i & 3); }

struct Unit { int pm, pn; };
struct Gemm { const bf16_t* A; const bf16_t* Bt; int M, N, K, lda; size_t astep; };

struct GroupOrder {
    int nunits, r, gsize, pm0;
    __device__ void init(int N_, int b, int r_, int gsize_) { nunits = 8 * (N_ / BM); r = r_; gsize = gsize_; pm0 = 8 * b; }
    __device__ bool next(int i, Unit& u) const { const int L = i * gsize + r; if (L >= nunits) return false; u.pm = pm0 + (L & 7); u.pn = L >> 3; return true; }
};
struct G1Order {
    int r, pm0;
    __device__ bool next(int i, Unit& u) const { if (i > 1) return false; const int L = i * 32 + r; if (L >= 56) return false; u.pm = pm0 + (r & 7); u.pn = ((L >> 3) + 5) % 7; return true; }
};
struct PairOrder { int pm, pn0, cnt; __device__ bool next(int i, Unit& u) const { if (i >= cnt) return false; u.pm = pm; u.pn = pn0 + i; return true; } };

constexpr float C2_A = 0.125f * LOG2E, C2_B = 0.125f * LOG2E, C2_C = 0.10206207261596575f * LOG2E;
template <int ACT  , int NP> struct EpiBf16 {
    static constexpr int BMAP = 1;
    bf16_t* O; int ldc; const float* ss; float inv_n; const LAS float* rsl;
    __device__ __forceinline__ void operator()(const f32x4 (&acc)[2][2][4][2], const Unit& u, int wr, int wc, int fr, int fq) const {
        const int row0 = u.pm * BM + wr * 64 + fr; const int col0 = u.pn * BM + wc * 32 + 8 * fq;
#pragma unroll
        for (int ai = 0; ai < 2; ++ai)
#pragma unroll
            for (int m = 0; m < 4; ++m) { const int row = row0 + ai * HALF + m * 16; bf16_t* rowp = O + (size_t)u.pm * BLKE + (size_t)(row & 255) * ldc + col0;
                float rs; if constexpr (NP == 0) rs = rsl[row & 255]; else rs = rsqrtf(ss_sum<NP>(ss + (size_t)row * NP) * inv_n + EPS);
#pragma unroll
                for (int bj = 0; bj < 2; ++bj) { f32x4 v0 = acc[ai][bj][m][0] * rs, v1 = acc[ai][bj][m][1] * rs;
                    if (ACT == 2) {
#pragma unroll
                        for (int i = 0; i < 4; ++i) { float a = fmaxf(v0[i], 0.f), b = fmaxf(v1[i], 0.f); v0[i] = a * a; v1[i] = b * b; } }
                    u32x4 w; w.x = cvt_pk_bf16(v0[0], v0[1]); w.y = cvt_pk_bf16(v0[2], v0[3]); w.z = cvt_pk_bf16(v1[0], v1[1]); w.w = cvt_pk_bf16(v1[2], v1[3]);
                    *(u32x4*)(rowp + bj * HALF) = w; } }
    }
};
struct EpiRes {
    static constexpr int BMAP = 1;
    const float* base; float* out; bf16_t* xb; float* ssn; int ldc; bool ntb;
    __device__ __forceinline__ void operator()(const f32x4 (&acc)[2][2][4][2], const Unit& u, int wr, int wc, int fr, int fq) const {
        const int row0 = u.pm * BM + wr * 64 + fr; const int col0 = u.pn * BM + wc * 32 + 8 * fq;
#pragma unroll
        for (int ai = 0; ai < 2; ++ai)
#pragma unroll
            for (int m = 0; m < 4; ++m) { const int row = row0 + ai * HALF + m * 16; const size_t off = (size_t)row * ldc + col0; float sq = 0.f;
#pragma unroll
                for (int bj = 0; bj < 2; ++bj) { f32x4 b0, b1; const f32x4* bp = (const f32x4*)(base + off + bj * HALF);
                    if (ntb) { b0 = __builtin_nontemporal_load(bp); b1 = __builtin_nontemporal_load(bp + 1); } else { b0 = bp[0]; b1 = bp[1]; }
                    const f32x4 o0 = b0 + acc[ai][bj][m][0], o1 = b1 + acc[ai][bj][m][1];
                    *(f32x4*)(out + off + bj * HALF) = o0; *(f32x4*)(out + off + bj * HALF + 4) = o1;
                    sq += ((o0[0] * o0[0] + o0[1] * o0[1]) + (o0[2] * o0[2] + o0[3] * o0[3])) + ((o1[0] * o1[0] + o1[1] * o1[1]) + (o1[2] * o1[2] + o1[3] * o1[3]));
                    u32x4 w; w.x = cvt_pk_bf16(o0[0], o0[1]); w.y = cvt_pk_bf16(o0[2], o0[3]); w.z = cvt_pk_bf16(o1[0], o1[1]); w.w = cvt_pk_bf16(o1[2], o1[3]);
                    *(u32x4*)(xb + off + bj * HALF) = w; }
                sq += __shfl_xor(sq, 16); sq += __shfl_xor(sq, 32);
                if (fq == 0) ssn[(size_t)row * 16 + u.pn * 4 + wc] = sq;
                if (m & 1) asm volatile("" ::: "memory"); }
    }
};
struct EpiRope {
    static constexpr int BMAP = 0;
    bf16_t* O; int ldc; const f32x2* rope; const float* ss;
    __device__ __forceinline__ void operator()(const f32x4 (&acc)[2][2][4][2], const Unit& u, int wr, int wc, int fr, int fq) const {
        const int row0 = u.pm * BM + wr * 64 + fr; const int col0 = u.pn * BM + wc * 32 + 4 * fq;
#pragma unroll
        for (int ai = 0; ai < 2; ++ai)
#pragma unroll
            for (int m = 0; m < 4; ++m) { const int row = row0 + ai * HALF + m * 16; const int t = row & (SEQ - 1);
                const float rs = rsqrtf(ss_sum<4>(ss + (size_t)row * 4) * (1.f / 256.f) + EPS) * C2_C;
                const f32x4 cs0 = *(const f32x4*)(rope + (size_t)t * 16 + 4 * fq), cs1 = *(const f32x4*)(rope + (size_t)t * 16 + 4 * fq + 2);
                const float cc[4] = {cs0[0], cs0[2], cs1[0], cs1[2]}, sn[4] = {cs0[1], cs0[3], cs1[1], cs1[3]};
#pragma unroll
                for (int bj = 0; bj < 2; ++bj) { const int g32 = u.pn * 8 + bj * 4 + wc; f32x4 a = acc[ai][bj][m][0] * rs, b = acc[ai][bj][m][1] * rs;
                    if (g32 < 12 && (g32 % 3) == 2) {
#pragma unroll
                        for (int i = 0; i < 4; ++i) { const float x1 = a[i], x2 = b[i]; a[i] = x1 * cc[i] - x2 * sn[i]; b[i] = x2 * cc[i] + x1 * sn[i]; } }
                    bf16_t* p = O + (size_t)u.pm * BLKE + (size_t)(row & 255) * ldc + col0 + bj * HALF;
                    u32x2 w0, w1; w0.x = cvt_pk_bf16(a[0], a[1]); w0.y = cvt_pk_bf16(a[2], a[3]); w1.x = cvt_pk_bf16(b[0], b[1]); w1.y = cvt_pk_bf16(b[2], b[3]);
                    *(u32x2*)p = w0; *(u32x2*)(p + 16) = w1; }
                asm volatile("" ::: "memory"); }
    }
};
struct EpiG1 {
    static constexpr int BMAP = 3;
    bf16_t* O; const LAS float* rsl; float* sscq; float* ssckv; const float* gq; const float* gk; const f32x2* rope;
    __device__ __forceinline__ void operator()(const f32x4 (&acc)[2][2][4][2], const Unit& u, int wr, int wc, int fr, int fq) const {
        const int g64 = u.pn * 4 + wc;
        const int row0 = u.pm * BM + wr * 64 + fr; const int lc = 8 * (fq & 1) + 32 * (fq >> 1);
        const bool isBq = (g64 >= 10 && g64 < 16), isBk = (g64 == 16 || g64 == 17), isNorm = isBq || isBk, isLat = (g64 >= 20 && g64 < 26), isKr = (g64 == 26);
        f32x4 gn[2][2];
#pragma unroll
        for (int bj = 0; bj < 2; ++bj)
#pragma unroll
            for (int n = 0; n < 2; ++n) gn[bj][n] = (f32x4){1.f, 1.f, 1.f, 1.f};
        if (isNorm) { const float* gp = (isBq ? gq : gk) + lc; const float sc = isBq ? C2_B : 1.f;
#pragma unroll
            for (int bj = 0; bj < 2; ++bj)
#pragma unroll
                for (int n = 0; n < 2; ++n) gn[bj][n] = *(const f32x4*)(gp + 4 * bj + 16 * n) * sc; }
        const float pre = (g64 < 6) ? C2_A : 1.f;
        const bool ropeLane = isNorm || (isKr && (fq >> 1) == 0);
#pragma unroll
        for (int ai = 0; ai < 2; ++ai)
#pragma unroll
            for (int m = 0; m < 4; ++m) { const int row = row0 + ai * HALF + m * 16; const int t = row & (SEQ - 1);
                const float rs = rsl[row & 255] * pre;
                f32x4 v[2][2];
#pragma unroll
                for (int bj = 0; bj < 2; ++bj)
#pragma unroll
                    for (int n = 0; n < 2; ++n) v[bj][n] = acc[ai][bj][m][n] * rs;
                if (isNorm || isLat) {
                    float sq = 0.f;
#pragma unroll
                    for (int bj = 0; bj < 2; ++bj)
#pragma unroll
                        for (int n = 0; n < 2; ++n) sq += (v[bj][n][0] * v[bj][n][0] + v[bj][n][1] * v[bj][n][1]) + (v[bj][n][2] * v[bj][n][2] + v[bj][n][3] * v[bj][n][3]);
                    sq += __shfl_xor(sq, 16); sq += __shfl_xor(sq, 32);
                    if (isLat) { if (fq == 0) { if (g64 < 24) sscq[(size_t)row * 4 + (g64 - 20)] = sq; else ssckv[(size_t)row * 2 + (g64 - 24)] = sq; } }
                    else { const float r2 = rsqrtf(sq * (1.f / 64.f) + EPS);
#pragma unroll
                        for (int bj = 0; bj < 2; ++bj)
#pragma unroll
                            for (int n = 0; n < 2; ++n) v[bj][n] = v[bj][n] * r2 * gn[bj][n]; }
                }
                if (isNorm || isKr) {
                    const int pos = isKr ? t : ((fq >> 1) ? (t & 63) : (t >> 6));
                    const f32x2* rp = rope + (size_t)pos * 16 + 8 * (fq & 1);
#pragma unroll
                    for (int bj = 0; bj < 2; ++bj) {
                        const f32x4 cs0 = *(const f32x4*)(rp + 4 * bj), cs1 = *(const f32x4*)(rp + 4 * bj + 2);
                        const float cc[4] = {cs0[0], cs0[2], cs1[0], cs1[2]}, sn[4] = {cs0[1], cs0[3], cs1[1], cs1[3]};
#pragma unroll
                        for (int i = 0; i < 4; ++i) { const float x1 = v[bj][0][i], x2 = v[bj][1][i]; const float y1 = x1 * cc[i] - x2 * sn[i], y2 = x2 * cc[i] + x1 * sn[i];
                            v[bj][0][i] = ropeLane ? y1 : x1; v[bj][1][i] = ropeLane ? y2 : x2; }
                    }
                }
                bf16_t* p = O + (size_t)u.pm * BLKE + (size_t)(row & 255) * PLD + g64 * 64 + lc;
#pragma unroll
                for (int n = 0; n < 2; ++n) { u32x4 w; w.x = cvt_pk_bf16(v[0][n][0], v[0][n][1]); w.y = cvt_pk_bf16(v[0][n][2], v[0][n][3]); w.z = cvt_pk_bf16(v[1][n][0], v[1][n][1]); w.w = cvt_pk_bf16(v[1][n][2], v[1][n][3]);
                    *(u32x4*)(p + 16 * n) = w; }
                asm volatile("" ::: "memory"); }
    }
};

template <class Epi, class Sched>
__device__ __forceinline__ void gemm_phase(LAS unsigned char* lds, const Gemm g, const Sched& S, const Epi& E, const float* rs_src = nullptr, LAS float* rs_dst = nullptr, unsigned* arr_first = nullptr) {
    int tid = threadIdx.x; asm volatile("" : "+v"(tid));
    const int wid = __builtin_amdgcn_readfirstlane(tid >> 6), lane = tid & 63, wr = wid >> 2, wc = wid & 3, fr = lane & 15, fq = lane >> 4;
    int K = g.K, lda = g.lda; asm volatile("" : "+s"(K), "+s"(lda)); const int nt = K / BK;
    unsigned voffA[2], voffB[2];
#pragma unroll
    for (int i = 0; i < 2; ++i) { int R, C; stage_rc(tid * 16 + i * 8192, R, C); const int Rb = (Epi::BMAP == 1) ? ((R & ~31) + perm32(R & 31)) : (Epi::BMAP == 3) ? (64 * (R >> 5) + (R & 3) + 8 * ((R >> 2) & 1) + 16 * ((R >> 4) & 1) + 32 * ((R >> 3) & 1)) : R;
        voffA[i] = (unsigned)(R * lda + C) * 2u; voffB[i] = (unsigned)(Rb * K + C) * 2u; }
    const size_t kstep = (size_t)(BK * 2);
    const size_t hstepA = (size_t)HALF * lda * 2, hstepB = (size_t)((Epi::BMAP == 3) ? 4 : HALF) * K * 2;
    const size_t tstepA = g.astep, tstepB = (size_t)BM * K * 2;
    const unsigned ldsw = (unsigned)wid * 1024u;
    const int aoff = lds_byte(wr * 64 + fr, fq * 8), boff = lds_byte(wc * 32 + fr, fq * 8);
#define PG8_SA(b, h) (((b) * 2 + (h)) * HTB)
#define PG8_SB(b, h) ((4 + (b) * 2 + (h)) * HTB)
#define PG8_STAGE(bufoff, gbase, voff) do { _Pragma("unroll") for (int _i = 0; _i < 2; ++_i) \
        __builtin_amdgcn_global_load_lds((const unsigned*)((const char*)(gbase) + (voff)[_i]), (LAS unsigned*)(lds + (bufoff) + ldsw + _i * 8192), 16, 0, 0); } while (0)
#define PG8_LDA(dst, b, h) do { _Pragma("unroll") for (int m = 0; m < 4; ++m) _Pragma("unroll") for (int k = 0; k < 2; ++k) dst[m][k] = *(const LAS bf16x8*)(lds + PG8_SA(b, h) + aoff + m * 2048 + k * 1024); } while (0)
#define PG8_LDB(dst, b, h) do { _Pragma("unroll") for (int n = 0; n < 2; ++n) _Pragma("unroll") for (int k = 0; k < 2; ++k) dst[n][k] = *(const LAS bf16x8*)(lds + PG8_SB(b, h) + boff + n * 2048 + k * 1024); } while (0)
#define PG8_MMA(ai, bj, At, Bt) do { __builtin_amdgcn_s_setprio(1); _Pragma("unroll") for (int m = 0; m < 4; ++m) _Pragma("unroll") for (int n = 0; n < 2; ++n) _Pragma("unroll") for (int k = 0; k < 2; ++k) \
        acc[ai][bj][m][n] = __builtin_amdgcn_mfma_f32_16x16x32_bf16(Bt[n][k], At[m][k], acc[ai][bj][m][n], 0, 0, 0); __builtin_amdgcn_s_setprio(0); } while (0)
#define PG8_WAIT_V(n) asm volatile("s_waitcnt vmcnt(" #n ")" ::: "memory")
#define PG8_WAIT_L(n) asm volatile("s_waitcnt lgkmcnt(" #n ")" ::: "memory")
#define PG8_BAR __builtin_amdgcn_s_barrier()
#define PG8_SCHED __builtin_amdgcn_sched_barrier(0)
    Unit cur, nxt; int ui = 0;
    if (!S.next(0, cur)) return;
    f32x4 acc[2][2][4][2];
#pragma unroll
    for (int a = 0; a < 2; ++a)
#pragma unroll
        for (int b = 0; b < 2; ++b)
#pragma unroll
            for (int m = 0; m < 4; ++m)
#pragma unroll
                for (int n = 0; n < 2; ++n) acc[a][b][m][n] = (f32x4){0.f, 0.f, 0.f, 0.f};
    bf16x8 At[4][2], B0[2][2], B1[2][2];
    const char* cA = (const char*)g.A + (size_t)cur.pm * tstepA; const char* cB = (const char*)g.Bt + (size_t)cur.pn * tstepB;
    PG8_STAGE(PG8_SB(0, 0), cB, voffB); PG8_STAGE(PG8_SB(0, 1), cB + hstepB, voffB); PG8_STAGE(PG8_SA(0, 0), cA, voffA); PG8_STAGE(PG8_SA(0, 1), cA + hstepA, voffA);
    f32x4 rsv[4] = {(f32x4){0.f, 0.f, 0.f, 0.f}, (f32x4){0.f, 0.f, 0.f, 0.f}, (f32x4){0.f, 0.f, 0.f, 0.f}, (f32x4){0.f, 0.f, 0.f, 0.f}};
    const bool rs_on = (rs_src != nullptr) && (wr == 0);
    if (rs_on) { const f32x4* rp = (const f32x4*)(rs_src + (size_t)tid * 16); rsv[0] = rp[0]; rsv[1] = rp[1]; rsv[2] = rp[2]; rsv[3] = rp[3]; }
    if (wr == 1) PG8_BAR;
    PG8_WAIT_V(2); PG8_BAR;
    PG8_STAGE(PG8_SB(1, 0), cB + kstep, voffB); PG8_STAGE(PG8_SA(1, 0), cA + kstep, voffA); PG8_STAGE(PG8_SB(1, 1), cB + hstepB + kstep, voffB);
    PG8_WAIT_V(6); PG8_BAR;
    if (rs_on) { float t_ = 0.f;
#pragma unroll
        for (int j = 0; j < 4; ++j) t_ += (rsv[j].x + rsv[j].y) + (rsv[j].z + rsv[j].w);
        rs_dst[tid] = rsqrtf(t_ * (1.f / DM) + EPS); }
    for (;;) {
        const bool has_next = S.next(ui + 1, nxt);
        const char* nA = has_next ? (const char*)g.A + (size_t)nxt.pm * tstepA : cA; const char* nB = has_next ? (const char*)g.Bt + (size_t)nxt.pn * tstepB : cB;
        for (int t = 0; t < nt; t += 2) {
            const bool last = (t == nt - 2);
            const char* a1 = cA + (size_t)(t + 1) * kstep;
            const char* a2 = last ? nA : cA + (size_t)(t + 2) * kstep; const char* b2 = last ? nB : cB + (size_t)(t + 2) * kstep;
            const char* a3 = a2 + kstep; const char* b3 = b2 + kstep;
            PG8_LDB(B0, 0, 0); PG8_LDB(B1, 0, 1); PG8_SCHED; PG8_LDA(At, 0, 0); PG8_STAGE(PG8_SA(1, 1), a1 + hstepA, voffA);
            PG8_WAIT_V(8); PG8_WAIT_L(0); PG8_BAR; PG8_MMA(0, 0, At, B0); PG8_MMA(0, 1, At, B1); PG8_BAR; PG8_SCHED;
            PG8_LDA(At, 0, 1); PG8_STAGE(PG8_SB(0, 0), b2, voffB); PG8_STAGE(PG8_SB(0, 1), b2 + hstepB, voffB); PG8_STAGE(PG8_SA(0, 0), a2, voffA);
            PG8_WAIT_V(8); PG8_WAIT_L(0); PG8_BAR; PG8_MMA(1, 0, At, B0); PG8_MMA(1, 1, At, B1); PG8_BAR; PG8_SCHED;
            PG8_LDB(B0, 1, 0); PG8_LDB(B1, 1, 1); PG8_SCHED; PG8_LDA(At, 1, 0); PG8_STAGE(PG8_SA(0, 1), a2 + hstepA, voffA);
            PG8_WAIT_V(8); PG8_WAIT_L(0); PG8_BAR; PG8_MMA(0, 0, At, B0); PG8_MMA(0, 1, At, B1); PG8_BAR; PG8_SCHED;
            PG8_LDA(At, 1, 1); PG8_STAGE(PG8_SB(1, 0), b3, voffB); PG8_STAGE(PG8_SB(1, 1), b3 + hstepB, voffB); PG8_STAGE(PG8_SA(1, 0), a3, voffA);
            PG8_WAIT_V(8); PG8_WAIT_L(0); PG8_BAR; PG8_MMA(1, 0, At, B0); PG8_MMA(1, 1, At, B1); PG8_BAR; PG8_SCHED;
        }
        if (wr == 0) PG8_BAR;
        { int fr_e = fr, fq_e = fq; asm volatile("" : "+v"(fr_e), "+v"(fq_e));
          E(acc, cur, wr, wc, fr_e, fq_e); }
        if (arr_first && ui == 0) quad_arrive(arr_first);
        if (!has_next) break;
#pragma unroll
        for (int a = 0; a < 2; ++a)
#pragma unroll
            for (int b = 0; b < 2; ++b)
#pragma unroll
                for (int m = 0; m < 4; ++m)
#pragma unroll
                    for (int n = 0; n < 2; ++n) acc[a][b][m][n] = (f32x4){0.f, 0.f, 0.f, 0.f};
        cur = nxt; cA = nA; cB = nB; ++ui;
        if (wr == 1) PG8_BAR;
    }
    PG8_WAIT_V(0);
    PG8_BAR;
#undef PG8_SA
#undef PG8_SB
#undef PG8_STAGE
#undef PG8_LDA
#undef PG8_LDB
#undef PG8_MMA
#undef PG8_WAIT_V
#undef PG8_WAIT_L
#undef PG8_BAR
#undef PG8_SCHED
}
}

struct AttnP { const bf16_t* Q; int ldq; const bf16_t* K1; int ldk1; const bf16_t* K2; int ldk2; const bf16_t* V; int ldv; bf16_t* O; int ldo; float slope2, sink2; };

__device__ __forceinline__ void lane32_swap(float& a, float& b) { asm volatile("s_nop 1\n\tv_permlane32_swap_b32 %0, %1\n\ts_nop 1" : "+v"(a), "+v"(b)); }
__device__ __forceinline__ float lane32_max(float v) { float a = v, b = v; lane32_swap(a, b); return fmaxf(a, b); }
__device__ __forceinline__ float lane32_sum(float v) { float a = v, b = v; lane32_swap(a, b); return a + b; }

template <int MODE>
__device__ __forceinline__ void attn_unit(LAS unsigned char* lds, const AttnP& P, int b, int qb, bool chain_in, bool chain_out, int& r0, int& r1, int& r2) {
    constexpr int DQK = (MODE == 2) ? 96 : 64, NKD = DQK / 16, NCH = DQK / 8, KTILE = NCH * 1024;
    constexpr int SLOT = KTILE + 8192;
    constexpr float THR = 12.f;
    int tid = threadIdx.x; asm volatile("" : "+v"(tid));
    const int lane = tid & 63, wid = __builtin_amdgcn_readfirstlane(tid >> 6), r32 = lane & 31, hi = lane >> 5;
    const int q0 = qb * 256, q0w = q0 + wid * 32;
    bf16x8 qr[NKD];
    const size_t qblk = (size_t)(8 * b + qb) * BLKE;
    { const bf16_t* qp = P.Q + qblk + (size_t)(wid * 32 + r32) * P.ldq + hi * 8;
#pragma unroll
      for (int d0 = 0; d0 < NKD; ++d0) qr[d0] = *(const bf16x8*)(qp + d0 * 16); }
    int t_lo = 0, t_hi = SEQ / 64;
    if (MODE == 0) { t_lo = 4 * qb - 2; if (t_lo < 0) t_lo = 0; t_hi = 4 * qb + 6; if (t_hi > SEQ / 64) t_hi = SEQ / 64; }
    const int NT = t_hi - t_lo;
    const bf16_t* ksrc0 = P.K1 + (size_t)(8 * b) * BLKE + (size_t)lane * P.ldk1 + wid * 8; const size_t kstr0 = (size_t)64 * P.ldk1;
    const bf16_t* ksrc1 = ksrc0; size_t kstr1 = 0;
    if (MODE == 2) { ksrc1 = P.K2 + (size_t)(8 * b) * BLKE + (size_t)lane * P.ldk2 + (wid & 3) * 8; kstr1 = (size_t)64 * P.ldk2; }
    const bf16_t* vsrc = P.V + (size_t)(8 * b) * BLKE + (size_t)(16 * (wid & 3) + (lane >> 2)) * P.ldv + (wid >> 2) * 32 + (lane & 3) * 8; const size_t vstr = (size_t)64 * P.ldv;
    const int kdst0 = wid * 1024, kdst1 = (8 + (wid & 3)) * 1024, vdst = KTILE + wid * 1024;
#define AT_DMA(t, so) do { const size_t tb_ = (size_t)((t) >> 2) * BLKE; const size_t tl_ = (size_t)((t) & 3); \
    __builtin_amdgcn_global_load_lds((const unsigned*)(ksrc0 + tb_ + tl_ * kstr0), (LAS unsigned*)(lds + (so) + kdst0), 16, 0, 0); \
    if (MODE == 2 && wid < 4) __builtin_amdgcn_global_load_lds((const unsigned*)(ksrc1 + tb_ + tl_ * kstr1), (LAS unsigned*)(lds + (so) + kdst1), 16, 0, 0); \
    __builtin_amdgcn_global_load_lds((const unsigned*)(vsrc + tb_ + tl_ * vstr), (LAS unsigned*)(lds + (so) + vdst), 16, 0, 0); } while (0)
#define AT_DMA_WAIT() asm volatile("s_waitcnt vmcnt(0)" ::: "memory")
    float m_i = (MODE == 0) ? P.sink2 : 0.f;
    float l_i = (MODE == 0 && hi == 0) ? 1.f : 0.f;
    f32x16 o0, o1, negm;
#pragma unroll
    for (int r = 0; r < 16; ++r) { o0[r] = 0.f; o1[r] = 0.f; negm[r] = -m_i; }
    const int kread = hi * 1024 + r32 * 16;
    const int vread = KTILE + (4 * hi + ((lane & 15) >> 2)) * 64 + ((lane >> 4) & 1) * 32 + (lane & 3) * 8;
    f32x16 pA0, pA1, pB0, pB1;
    bf16x8 pf00, pf01, pf10, pf11;
#define AT_SBAR() __builtin_amdgcn_sched_barrier(0)
#define AT_QKT(X0, X1, so) do { const LAS unsigned char* kb_ = lds + (so) + kread; X0 = negm; X1 = negm; \
    _Pragma("unroll") for (int d0 = 0; d0 < NKD; ++d0) { \
        const bf16x8 k0_ = *(const LAS bf16x8*)(kb_ + d0 * 2048), k1_ = *(const LAS bf16x8*)(kb_ + d0 * 2048 + 512); \
        X0 = __builtin_amdgcn_mfma_f32_32x32x16_bf16(k0_, qr[d0], X0, 0, 0, 0); X1 = __builtin_amdgcn_mfma_f32_32x32x16_bf16(k1_, qr[d0], X1, 0, 0, 0); } } while (0)
#define AT_PSM(X0, X1, t, FIRST) do { \
    if (MODE == 0) { const float fd_ = (float)(64 * (t) + 4 * hi - (q0w + r32)); \
        _Pragma("unroll") for (int r = 0; r < 16; ++r) { const float x0_ = fd_ + (float)((r & 3) + 8 * (r >> 2)), x1_ = x0_ + 32.f; \
            const float s0_ = __builtin_fmaf(-P.slope2, __builtin_fabsf(x0_), X0[r]), s1_ = __builtin_fmaf(-P.slope2, __builtin_fabsf(x1_), X1[r]); \
            X0[r] = (__builtin_fabsf(x0_) <= 128.f) ? s0_ : -1e30f; X1[r] = (__builtin_fabsf(x1_) <= 128.f) ? s1_ : -1e30f; } } \
    float mx_ = fmaxf(X0[0], X1[0]), my_ = fmaxf(X0[1], X1[1]); \
    _Pragma("unroll") for (int r = 2; r < 16; r += 2) { mx_ = fmaxf(fmaxf(mx_, X0[r]), X1[r]); my_ = fmaxf(fmaxf(my_, X0[r + 1]), X1[r + 1]); }     \
    mx_ = lane32_max(fmaxf(mx_, my_)); \
    if ((FIRST) || __any(mx_ > THR)) { \
        const float dl_ = (FIRST) ? mx_ : fmaxf(mx_, 0.f); m_i += dl_; \
        if (!(FIRST)) { const float al_ = __builtin_amdgcn_exp2f(-dl_); l_i *= al_; \
            _Pragma("unroll") for (int r = 0; r < 16; ++r) { o0[r] *= al_; o1[r] *= al_; } } \
        _Pragma("unroll") for (int r = 0; r < 16; ++r) { X0[r] -= dl_; X1[r] -= dl_; negm[r] = -m_i; } } \
    _Pragma("unroll") for (int r = 0; r < 16; ++r) X0[r] = __builtin_amdgcn_exp2f(X0[r]); } while (0)
#define AT_PKF(X, s_) __builtin_bit_cast(bf16x8, (u32x4){cvt_pk_bf16(X[8 * (s_) + 0], X[8 * (s_) + 1]), cvt_pk_bf16(X[8 * (s_) + 2], X[8 * (s_) + 3]), cvt_pk_bf16(X[8 * (s_) + 4], X[8 * (s_) + 5]), cvt_pk_bf16(X[8 * (s_) + 6], X[8 * (s_) + 7])})
#define AT_FSM(X0, X1) do { \
    _Pragma("unroll") for (int r = 0; r < 16; ++r) X1[r] = __builtin_amdgcn_exp2f(X1[r]); \
    float ls_ = X0[0];     \
    _Pragma("unroll") for (int r = 1; r < 16; ++r) ls_ += X0[r]; \
    _Pragma("unroll") for (int r = 0; r < 16; ++r) ls_ += X1[r]; \
    l_i += ls_; \
    pf00 = AT_PKF(X0, 0); pf01 = AT_PKF(X0, 1); pf10 = AT_PKF(X1, 0); pf11 = AT_PKF(X1, 1); } while (0)
#define AT_VF(vp_) ({ const s16x4 lo_ = __builtin_bit_cast(s16x4, __builtin_amdgcn_ds_read_tr16_b64_v4i16((LAS s16x4*)(vp_))); \
    const s16x4 hh_ = __builtin_bit_cast(s16x4, __builtin_amdgcn_ds_read_tr16_b64_v4i16((LAS s16x4*)((vp_) + 512))); \
    (bf16x8){lo_[0], lo_[1], lo_[2], lo_[3], hh_[0], hh_[1], hh_[2], hh_[3]}; })
#define AT_PV(so) do { const LAS unsigned char* vb_ = lds + (so) + vread; \
    o0 = __builtin_amdgcn_mfma_f32_32x32x16_bf16(AT_VF(vb_), pf00, o0, 0, 0, 0); o1 = __builtin_amdgcn_mfma_f32_32x32x16_bf16(AT_VF(vb_ + 4096), pf00, o1, 0, 0, 0); \
    o0 = __builtin_amdgcn_mfma_f32_32x32x16_bf16(AT_VF(vb_ + 1024), pf01, o0, 0, 0, 0); o1 = __builtin_amdgcn_mfma_f32_32x32x16_bf16(AT_VF(vb_ + 4096 + 1024), pf01, o1, 0, 0, 0); \
    o0 = __builtin_amdgcn_mfma_f32_32x32x16_bf16(AT_VF(vb_ + 2048), pf10, o0, 0, 0, 0); o1 = __builtin_amdgcn_mfma_f32_32x32x16_bf16(AT_VF(vb_ + 4096 + 2048), pf10, o1, 0, 0, 0); \
    o0 = __builtin_amdgcn_mfma_f32_32x32x16_bf16(AT_VF(vb_ + 3072), pf11, o0, 0, 0, 0); o1 = __builtin_amdgcn_mfma_f32_32x32x16_bf16(AT_VF(vb_ + 4096 + 3072), pf11, o1, 0, 0, 0); } while (0)
    int sl_prev = chain_in ? r0 : 0, sl_cur = chain_in ? r1 : SLOT, sl_next = chain_in ? r2 : 2 * SLOT;
#define AT_ROT() do { const int t_ = sl_prev; sl_prev = sl_cur; sl_cur = sl_next; sl_next = t_; } while (0)
#define AT_STEP(X0, X1, Y0, Y1, i) do { \
    if ((i) + 1 < NT) AT_DMA(t_lo + (i) + 1, sl_next);        \
    AT_SBAR(); AT_QKT(X0, X1, sl_cur); AT_FSM(Y0, Y1); AT_SBAR(); \
    AT_PV(sl_prev); AT_PSM(X0, X1, t_lo + (i), false); AT_SBAR(); \
    AT_DMA_WAIT(); __syncthreads(); AT_ROT(); } while (0)
    if (!chain_in) { AT_DMA(t_lo, sl_prev); AT_DMA(t_lo + 1, sl_cur); }
    AT_DMA_WAIT(); __syncthreads();
    AT_QKT(pA0, pA1, sl_prev);
    AT_PSM(pA0, pA1, t_lo, (MODE != 0));
    {
        int i = 1;
        for (; i + 1 < NT; i += 2) { AT_STEP(pB0, pB1, pA0, pA1, i); AT_STEP(pA0, pA1, pB0, pB1, i + 1); }
        AT_STEP(pB0, pB1, pA0, pA1, i);
    }
    if (chain_out) { AT_DMA(t_lo, sl_cur); AT_DMA(t_lo + 1, sl_next); r0 = sl_cur; r1 = sl_next; r2 = sl_prev; }
    AT_FSM(pB0, pB1);
    AT_PV(sl_prev);
#undef AT_DMA
#undef AT_DMA_WAIT
#undef AT_SBAR
#undef AT_QKT
#undef AT_PSM
#undef AT_PKF
#undef AT_FSM
#undef AT_VF
#undef AT_PV
#undef AT_ROT
#undef AT_STEP
    const float lt = lane32_sum(l_i);
    const float inv = 1.0f / lt;
    bf16_t* op = P.O + qblk + (size_t)(wid * 32 + r32) * P.ldo + 4 * hi;
#pragma unroll
    for (int g = 0; g < 4; ++g) {
        u32x2 w0, w1;
        w0.x = cvt_pk_bf16(o0[4 * g] * inv, o0[4 * g + 1] * inv); w0.y = cvt_pk_bf16(o0[4 * g + 2] * inv, o0[4 * g + 3] * inv);
        w1.x = cvt_pk_bf16(o1[4 * g] * inv, o1[4 * g + 1] * inv); w1.y = cvt_pk_bf16(o1[4 * g + 2] * inv, o1[4 * g + 3] * inv);
        *(u32x2*)(op + 8 * g) = w0; *(u32x2*)(op + 32 + 8 * g) = w1;
    }
    if (!chain_out) __syncthreads();
}

#define XB_TMO      128
#define XB_XCNT(j)  (256  + 64 * (j))
#define XB_XSUB(j)  (1280 + 64 * (j))
#define XB_XGEN(j)  (2304 + 64 * (j))
#define XB_TOP      3328
#define XB_TOPGEN   3392
#define XCD_BAR_WORDS 3456
#define XB_SPIN_CAP (1u << 18)
__device__ __forceinline__ unsigned xb_ld(unsigned* p)              { return __hip_atomic_load(p, __ATOMIC_RELAXED, __HIP_MEMORY_SCOPE_AGENT); }
__device__ __forceinline__ unsigned xb_add(unsigned* p, unsigned v) { return __hip_atomic_fetch_add(p, v, __ATOMIC_RELAXED, __HIP_MEMORY_SCOPE_AGENT); }
__device__ __forceinline__ unsigned xb_xcc_id() { return (unsigned)__builtin_amdgcn_s_getreg((3 << 11) | 20) & 0xFu; }
#define XB_SPIN(cond, bar) do { unsigned _sp = 0; while (cond) { __builtin_amdgcn_s_sleep(1); \
    if ((++_sp & 255u) == 0u) { if (xb_ld(&(bar)[XB_TMO])) break; if (_sp > XB_SPIN_CAP) { atomicAdd(&(bar)[XB_TMO], 1u); break; } } } } while (0)
struct XcdBarrier { unsigned* bar; unsigned x; volatile LAS unsigned* st; unsigned rank; };
__device__ __forceinline__ XcdBarrier xcd_barrier_post(unsigned* bar, volatile LAS unsigned* st) {
    XcdBarrier b; b.bar = bar; b.st = st; b.rank = 0u;
    unsigned x_ = xb_xcc_id(); asm volatile("" : "+s"(x_)); b.x = x_;
    if (threadIdx.x == 0) b.rank = xb_add(&bar[XB_XCNT(b.x)], 1u);
    return b;
}
__device__ __forceinline__ void xcd_barrier_complete(unsigned* bar, unsigned x, unsigned& nloc, unsigned& nx) {
    const unsigned G = gridDim.x * gridDim.y * gridDim.z;
    unsigned sum, cnt, mine, sp = 0u;
    for (;;) {
        sum = 0u; cnt = 0u; mine = 0u;
#pragma unroll
        for (unsigned j = 0; j < 16; ++j) { const unsigned c = xb_ld(&bar[XB_XCNT(j)]); sum += c; cnt += (c > 0u) ? 1u : 0u; mine = (j == x) ? c : mine; }
        if (sum == G) break;
        __builtin_amdgcn_s_sleep(1);
        if ((++sp & 255u) == 0u) { if (xb_ld(&bar[XB_TMO])) break; if (sp > XB_SPIN_CAP) { atomicAdd(&bar[XB_TMO], 1u); break; } }
    }
    nloc = mine > 0u ? mine : 1u; nx = cnt > 0u ? cnt : 1u;
}
__device__ __forceinline__ void xcd_barrier(const XcdBarrier& b) {
    asm volatile("s_waitcnt vmcnt(0)" ::: "memory");
    __syncthreads();
    if (threadIdx.x == 0) {
        unsigned* bar = b.bar; asm volatile("" : "+s"(bar));
        __builtin_amdgcn_s_waitcnt(0);
        unsigned nloc = b.st[0], nx = b.st[1];
        if (nloc == 0u) { xcd_barrier_complete(bar, b.x, nloc, nx); b.st[0] = nloc; b.st[1] = nx; }
        const unsigned old = xb_add(&bar[XB_XSUB(b.x)], 1u);
        const unsigned gen = old / nloc;
        if (old + 1u == (gen + 1u) * nloc) {
            __builtin_amdgcn_fence(__ATOMIC_RELEASE, "agent");
            asm volatile("s_waitcnt vmcnt(0)" ::: "memory");
            const unsigned og = xb_add(&bar[XB_TOP], 1u);
            const unsigned tg = og / nx;
            if (og + 1u == (tg + 1u) * nx) xb_add(&bar[XB_TOPGEN], 1u);
            else XB_SPIN(xb_ld(&bar[XB_TOPGEN]) == tg, bar);
            __builtin_amdgcn_fence(__ATOMIC_ACQUIRE, "agent");
            xb_add(&bar[XB_XGEN(b.x)], 1u);
            asm volatile("s_waitcnt vmcnt(0)" ::: "memory");
        } else {
            XB_SPIN(xb_ld(&bar[XB_XGEN(b.x)]) == gen, bar);
            __builtin_amdgcn_fence(__ATOMIC_ACQUIRE, "agent");
            asm volatile("s_waitcnt vmcnt(0)" ::: "memory");
        }
    }
    __syncthreads();
}

__device__ __forceinline__ void local_barrier(unsigned* arr, unsigned* gen_w, unsigned* tmo, unsigned nloc) {
    asm volatile("s_waitcnt vmcnt(0)" ::: "memory");
    __syncthreads();
    if (threadIdx.x == 0) {
        __builtin_amdgcn_s_waitcnt(0);
        const unsigned old = xb_add(arr, 1u);
        const unsigned gen = old / nloc;
        if (old + 1u == (gen + 1u) * nloc) xb_add(gen_w, 1u);
        else { unsigned sp_ = 0; while (xb_ld(gen_w) == gen) { __builtin_amdgcn_s_sleep(1); if ((++sp_ & 255u) == 0u) { if (xb_ld(tmo)) break; if (sp_ > XB_SPIN_CAP) { atomicAdd(tmo, 1u); break; } } } }
        __builtin_amdgcn_fence(__ATOMIC_ACQUIRE, "agent");
        asm volatile("s_waitcnt vmcnt(0)" ::: "memory");
    }
    __syncthreads();
}

__device__ __forceinline__ void quad_arrive(unsigned* arr) {
    asm volatile("s_waitcnt vmcnt(0)" ::: "memory");
    __syncthreads();
    if (threadIdx.x == 0) (void)__hip_atomic_fetch_add(arr, 1u, __ATOMIC_RELAXED, __HIP_MEMORY_SCOPE_AGENT);
}
__device__ __forceinline__ void quad_wait(unsigned* arr, unsigned expect, unsigned* tmo) {
    if (threadIdx.x == 0) {
        unsigned sp_ = 0;
        while (xb_ld(arr) < expect) { __builtin_amdgcn_s_sleep(1); if ((++sp_ & 255u) == 0u) { if (xb_ld(tmo)) break; if (sp_ > XB_SPIN_CAP) { atomicAdd(tmo, 1u); break; } } }
        __builtin_amdgcn_fence(__ATOMIC_ACQUIRE, "agent");
        asm volatile("s_waitcnt vmcnt(0)" ::: "memory");
    }
    __syncthreads();
}

struct EpiResFinal {
    static constexpr int BMAP = 1;
    const float* base; float* out; float* ssn; const float* gain; int ldc;
    bool fast; unsigned* qarr; unsigned qexpect; unsigned* tmo; XcdBarrier xbar;
    __device__ __forceinline__ void operator()(f32x4 (&acc)[2][2][4][2], const pg8::Unit& u, int wr, int wc, int fr, int fq) const {
        const int row0 = u.pm * pg8::BM + wr * 64 + fr; const int col0 = u.pn * pg8::BM + wc * 32 + 8 * fq;
#pragma unroll
        for (int ai = 0; ai < 2; ++ai)
#pragma unroll
            for (int m = 0; m < 4; ++m) { const int row = row0 + ai * pg8::HALF + m * 16; const size_t off = (size_t)row * ldc + col0; float sq = 0.f;
#pragma unroll
                for (int bj = 0; bj < 2; ++bj) { const f32x4 b0 = *(const f32x4*)(base + off + bj * pg8::HALF), b1 = *(const f32x4*)(base + off + bj * pg8::HALF + 4);
                    const f32x4 o0 = b0 + acc[ai][bj][m][0], o1 = b1 + acc[ai][bj][m][1];
                    acc[ai][bj][m][0] = o0; acc[ai][bj][m][1] = o1;
                    sq += ((o0[0] * o0[0] + o0[1] * o0[1]) + (o0[2] * o0[2] + o0[3] * o0[3])) + ((o1[0] * o1[0] + o1[1] * o1[1]) + (o1[2] * o1[2] + o1[3] * o1[3])); }
                sq += __shfl_xor(sq, 16); sq += __shfl_xor(sq, 32);
                if (fq == 0) ssn[(size_t)row * 16 + u.pn * 4 + wc] = sq;
                if (m & 1) asm volatile("" ::: "memory"); }
        if (fast) { quad_arrive(qarr); quad_wait(qarr, qexpect, tmo); } else xcd_barrier(xbar);
        f32x4 g[2][2];
#pragma unroll
        for (int bj = 0; bj < 2; ++bj) { g[bj][0] = *(const f32x4*)(gain + col0 + bj * pg8::HALF); g[bj][1] = *(const f32x4*)(gain + col0 + bj * pg8::HALF + 4); }
#pragma unroll
        for (int ai = 0; ai < 2; ++ai)
#pragma unroll
            for (int m = 0; m < 4; ++m) { const int row = row0 + ai * pg8::HALF + m * 16; const size_t off = (size_t)row * ldc + col0;
                const float rs = rsqrtf(ss_sum<16>(ssn + (size_t)row * 16) * (1.f / DM) + EPS);
#pragma unroll
                for (int bj = 0; bj < 2; ++bj) { *(f32x4*)(out + off + bj * pg8::HALF) = acc[ai][bj][m][0] * rs * g[bj][0]; *(f32x4*)(out + off + bj * pg8::HALF + 4) = acc[ai][bj][m][1] * rs * g[bj][1]; }
                if (m & 1) asm volatile("" ::: "memory"); }
    }
};

constexpr int NWAVES = 8, NTHREADS = 512;
constexpr int LDS_BYTES = 147456;
constexpr int LDS_MISC = 131072;

struct Args { const float* in[15]; float* out; unsigned char* ws; int never, pad; };

__device__ __forceinline__ float wave_sum(float v) {
#pragma unroll
    for (int o = 1; o < 64; o <<= 1) v += __shfl_xor(v, o);
    return v;
}
struct WItem { const float* W; const float* gain; bf16_t* WT; int N, ldk, k0, n0; };
__device__ __forceinline__ WItem witem(int N, int ldk, const float* W, const float* gain, bf16_t* WT, int item) {
    WItem d; const int nblk = N / 32; d.W = W; d.gain = gain; d.WT = WT; d.N = N; d.ldk = ldk; d.k0 = 64 * (item / nblk); d.n0 = 32 * (item % nblk); return d;
}
#define WI_LOAD(v, gv, d) do { const float* wp_ = (d).W + (size_t)((d).k0 + (lane >> 5)) * (d).N + (d).n0 + (lane & 31); \
    _Pragma("unroll") for (int i = 0; i < 32; ++i) v[i] = __builtin_nontemporal_load(wp_ + (size_t)(2 * i) * (d).N);     \
    gv = (d).gain ? (d).gain[(d).k0 + lane] : 1.f; } while (0)
#define WI_PROC(v, gv, d) do { \
    _Pragma("unroll") for (int i = 0; i < 32; ++i) { const float g0_ = __builtin_bit_cast(float, __builtin_amdgcn_readlane(__builtin_bit_cast(int, gv), 2 * i)), g1_ = __builtin_bit_cast(float, __builtin_amdgcn_readlane(__builtin_bit_cast(int, gv), 2 * i + 1)); \
        scr[(2 * i + (lane >> 5)) * 33 + (lane & 31)] = v[i] * ((lane >> 5) ? g1_ : g0_); } \
    asm volatile("s_waitcnt lgkmcnt(0)" ::: "memory"); \
    { const int c_ = lane & 7; \
      _Pragma("unroll") for (int j = 0; j < 4; ++j) { const int n_ = (lane >> 3) + 8 * j; const LAS float* sp_ = scr + (8 * c_) * 33 + n_; \
        u32x4 o_; o_.x = pk2(sp_[0 * 33], sp_[1 * 33]); o_.y = pk2(sp_[2 * 33], sp_[3 * 33]); o_.z = pk2(sp_[4 * 33], sp_[5 * 33]); o_.w = pk2(sp_[6 * 33], sp_[7 * 33]); \
        *(u32x4*)((d).WT + (size_t)((d).n0 + n_) * (d).ldk + (d).k0 + 8 * c_) = o_; } } \
    asm volatile("s_waitcnt lgkmcnt(0)" ::: "memory"); } while (0)

__device__ __forceinline__ void row_to_bf16_ss(const float* xrow, bf16_t* orow, float* ssp, int lane) {
    const f32x4* xr = (const f32x4*)xrow + lane;
    f32x4 v[4]; float sq = 0.f;
#pragma unroll
    for (int j = 0; j < 4; ++j) { v[j] = __builtin_nontemporal_load(xr + 64 * j); sq += (v[j].x * v[j].x + v[j].y * v[j].y) + (v[j].z * v[j].z + v[j].w * v[j].w); }
    sq = wave_sum(sq);
    u32x2* o8 = (u32x2*)orow + lane;
#pragma unroll
    for (int j = 0; j < 4; ++j) { u32x2 w; w.x = cvt_pk_bf16(v[j].x, v[j].y); w.y = cvt_pk_bf16(v[j].z, v[j].w); o8[64 * j] = w; }
    if (lane < 16) ssp[lane] = (lane == 0) ? sq : 0.f;
}
__device__ __forceinline__ void final_row(float* xrow, const float* gain, float ssv, int lane) {
    f32x4* xr = (f32x4*)xrow + lane; const f32x4* gr = (const f32x4*)gain + lane;
    const float rstd = rsqrtf(ssv * (1.f / DM) + EPS);
#pragma unroll
    for (int j = 0; j < 4; ++j) { const f32x4 g = gr[64 * j]; xr[64 * j] = xr[64 * j] * rstd * g; }
}

__global__ void __launch_bounds__(NTHREADS, 2) fwd_kernel(Args args) {
    extern __shared__ __attribute__((aligned(16))) unsigned char lds_raw[];
    LAS unsigned char* lds = (LAS unsigned char*)lds_raw;
    cg::grid_group grid = cg::this_grid();
    const int wave = __builtin_amdgcn_readfirstlane((int)threadIdx.x >> 6);
    const int G = gridDim.x, bx = blockIdx.x;
    const int gw = bx * NWAVES + wave, NGW = G * NWAVES;
    unsigned* ctl0 = (unsigned*)(args.ws + WS_CTL);
    if (args.never != 0) grid.sync();
    { volatile LAS unsigned* st = (volatile LAS unsigned*)(lds + LDS_MISC + 64); if (threadIdx.x < 2) st[threadIdx.x] = 0u; }
    __syncthreads();
    XcdBarrier xbar = xcd_barrier_post(ctl0 + CW_BAR, (volatile LAS unsigned*)(lds + LDS_MISC + 64));
typedef const Args __attribute__((address_space(4))) KArgs;
#define PH_BEGIN { int tid = threadIdx.x; asm volatile("" : "+v"(tid)); const int lane = tid & 63; (void)lane; \
    KArgs* ap_ = (KArgs*)__builtin_amdgcn_kernarg_segment_ptr(); asm volatile("" : "+s"(ap_)); \
    unsigned char* ws = ap_->ws; float* out = ap_->out; (void)out; \
    const float* x_in = ap_->in[0]; const float* attn_norm = ap_->in[1]; const float* w_in = ap_->in[2]; const float* a_sink = ap_->in[3]; \
    const float* b_q_norm = ap_->in[4]; const float* b_k_norm = ap_->in[5]; const float* c_q_norm = ap_->in[6]; const float* c_kv_norm = ap_->in[7]; \
    const float* w_uq = ap_->in[8]; const float* w_ukv = ap_->in[9]; const float* w_out = ap_->in[10]; const float* mlp_norm = ap_->in[11]; \
    const float* w_ff1 = ap_->in[12]; const float* w_ff2 = ap_->in[13]; const float* final_norm = ap_->in[14]; \
    (void)x_in; (void)attn_norm; (void)w_in; (void)a_sink; (void)b_q_norm; (void)b_k_norm; (void)c_q_norm; (void)c_kv_norm; (void)w_uq; (void)w_ukv; (void)w_out; (void)mlp_norm; (void)w_ff1; (void)w_ff2; (void)final_norm; \
    unsigned* ctl = (unsigned*)(ws + WS_CTL); f32x2* rope = (f32x2*)(ws + WS_ROPE); (void)ctl; (void)rope; \
    float* SSA = (float*)(ws + WS_SSA); float* SSM = (float*)(ws + WS_SSM); float* SSCQ = (float*)(ws + WS_SSCQ); float* SSCKV = (float*)(ws + WS_SSCKV); (void)SSA; (void)SSM; (void)SSCQ; (void)SSCKV; \
    bf16_t* XN = (bf16_t*)(ws + WS_XN); bf16_t* U = (bf16_t*)(ws + WS_U); bf16_t* Pb = (bf16_t*)(ws + WS_U + SUB_P); (void)XN; (void)U; (void)Pb; \
    bf16_t* CQ = (bf16_t*)(ws + WS_U + SUB_CQ); bf16_t* CKV = (bf16_t*)(ws + WS_U + SUB_CKV); bf16_t* MIX = (bf16_t*)(ws + WS_U + SUB_MIX); (void)CQ; (void)CKV; (void)MIX;
#define PH_END_GRID xcd_barrier(xbar); }
#define PH_END_GROUP if (fast) local_barrier(ctl + CW_BAR2 + XB_XSUB(xbar.x), ctl + CW_BAR2 + XB_XGEN(xbar.x), ctl + CW_BAR2 + XB_TMO, 32u); else xcd_barrier(xbar); }
#define PH_END_QUAD if (fast) local_barrier(ctl + CW_BAR3 + 128 * (8 * grp + (rk & 7)), ctl + CW_BAR3 + 128 * (8 * grp + (rk & 7)) + 64, ctl + CW_BAR2 + XB_TMO, 4u); else xcd_barrier(xbar); }

    PH_BEGIN
    {
        LAS float* scr = (LAS float*)(lds + wave * 16384);
        constexpr int I_IN = 16 * 53, I_UQ = 4 * 12, I_UKV = 2 * 16, I_OUT = 16 * 32, I_F1 = 16 * 128, I_F2 = 64 * 32;
        constexpr int PER_L = I_IN + I_UQ + I_UKV + I_OUT + I_F1 + I_F2;
#define WI_DECODE(it_, d_) do { const int l_ = (it_) / PER_L; int r_ = (it_) % PER_L; unsigned char* wl_ = ws + WS_W + (size_t)l_ * W_LAYER; \
            if (r_ < I_IN) d_ = witem(IN_COLS, DM, w_in + (size_t)l_ * DM * IN_COLS, attn_norm + l_ * DM, (bf16_t*)(wl_ + WO_IN), r_); \
            else if ((r_ -= I_IN) < I_UQ) d_ = witem(384, 256, w_uq + (size_t)l_ * 256 * 384, c_q_norm + l_ * 256, (bf16_t*)(wl_ + WO_UQ), r_); \
            else if ((r_ -= I_UQ) < I_UKV) d_ = witem(512, 128, w_ukv + (size_t)l_ * 128 * 512, c_kv_norm + l_ * 128, (bf16_t*)(wl_ + WO_UKV), r_); \
            else if ((r_ -= I_UKV) < I_OUT) d_ = witem(DM, DM, w_out + (size_t)l_ * DM * DM, nullptr, (bf16_t*)(wl_ + WO_OUT), r_); \
            else if ((r_ -= I_OUT) < I_F1) d_ = witem(FF, DM, w_ff1 + (size_t)l_ * DM * FF, mlp_norm + l_ * DM, (bf16_t*)(wl_ + WO_FF1), r_); \
            else d_ = witem(DM, FF, w_ff2 + (size_t)l_ * FF * DM, nullptr, (bf16_t*)(wl_ + WO_FF2), r_ - I_F1); } while (0)
        {
            constexpr int TOT = DEPTH * PER_L;
            float va[32], vb[32], ga = 1.f, gb = 1.f; WItem da, db;
            int it = gw;
            if (it < TOT) { WI_DECODE(it, da); WI_LOAD(va, ga, da); }
            while (it < TOT) {
                const int itn = it + NGW; const bool hn = itn < TOT;
                if (hn) { WI_DECODE(itn, db); WI_LOAD(vb, gb, db); }
                WI_PROC(va, ga, da);
                if (!hn) break;
                it = itn; da = db; ga = gb;
#pragma unroll
                for (int i = 0; i < 32; ++i) va[i] = vb[i];
            }
        }
#undef WI_DECODE
        {
            constexpr int Z_IN = 96 * 1024 / 8, Z_UQ = 128 * 256 / 8, Z_L = Z_IN + Z_UQ;
            const int gt = bx * NTHREADS + tid, NGT = G * NTHREADS;
            for (int it = gt; it < DEPTH * Z_L; it += NGT) {
                const int l = it / Z_L; int r = it % Z_L; unsigned char* wl = ws + WS_W + (size_t)l * W_LAYER;
                u32x4* dst;
                if (r < Z_IN) dst = (u32x4*)(wl + WO_IN + (size_t)IN_COLS * DM * 2) + r;
                else dst = (u32x4*)(wl + WO_UQ + (size_t)384 * 256 * 2) + (r - Z_IN);
                *dst = (u32x4){0u, 0u, 0u, 0u};
            }
            for (int it = gt; it < 2048 * 16; it += NGT) {
                const int p = it >> 4, j = it & 15;
                const float inv = (float)exp(-(double)j * (9.210340371976184 / 16.0));
                const float ang = (float)p * inv;
                double rev = (double)ang * 0.15915494309189535; rev -= floor(rev);
                const float rf = (float)rev;
                rope[it] = (f32x2){__builtin_amdgcn_cosf(rf), __builtin_amdgcn_sinf(rf)};
            }
        }
        for (int m = gw; m < M; m += NGW) row_to_bf16_ss(x_in + (size_t)m * DM, XN + (size_t)m * DM, SSA + (size_t)m * 16, lane);
        __syncthreads();
    }
    PH_END_GRID

    {
        volatile LAS unsigned* gi = (volatile LAS unsigned*)(lds + LDS_MISC + 128);
        if (threadIdx.x == 0) {
            unsigned* bar = ctl0 + CW_BAR; unsigned npop = 0u, below = 0u; bool all32 = true;
            for (unsigned j = 0; j < 16; ++j) { const unsigned c = xb_ld(&bar[XB_XCNT(j)]); if (c) { ++npop; if (j < xbar.x) ++below; if (c != 32u) all32 = false; } }
            const bool f = (G == 256) && (npop == 8u) && all32 && (xb_ld(&bar[XB_TMO]) == 0u);
            const int gsz = 32;
            gi[0] = f ? 1u : 0u; gi[1] = f ? below : (unsigned)(bx / gsz); gi[2] = f ? xbar.rank : (unsigned)(bx % gsz); gi[3] = (unsigned)gsz; gi[4] = (unsigned)(G / gsz);
        }
        __syncthreads();
    }
    const volatile LAS unsigned* gi_ = (const volatile LAS unsigned*)(lds + LDS_MISC + 128);
    const bool fast = __builtin_amdgcn_readfirstlane(gi_[0]) != 0u;
    const int grp = __builtin_amdgcn_readfirstlane(gi_[1]), rk = __builtin_amdgcn_readfirstlane(gi_[2]), gsize = __builtin_amdgcn_readfirstlane(gi_[3]), ngroups = __builtin_amdgcn_readfirstlane(gi_[4]);

    int nsteps = 6 * DEPTH; asm volatile("" : "+s"(nsteps));
    unsigned qn = 0u;
    for (int step = 0; step < nsteps; ++step) {
        const int l = step / 6, kind = step % 6;
        PH_BEGIN
        const unsigned char* wl = ws + WS_W + (size_t)l * W_LAYER;
        for (int b = grp; b < BATCH; b += ngroups) {
            if (kind <= 1) {
                if (kind == 0) {
                    pg8::Gemm g{XN, (const bf16_t*)(wl + WO_IN), M, PLD, DM, DM, (size_t)256 * DM * 2}; pg8::G1Order S{rk, 8 * b};
                    LAS float* rsl = (LAS float*)(lds + LDS_MISC + 1024);
                    pg8::EpiG1 E{Pb, rsl, SSCQ, SSCKV, b_q_norm + l * 64, b_k_norm + l * 64, rope};
                    pg8::gemm_phase(lds, g, S, E, SSA + (size_t)(8 * b + (rk & 7)) * 256 * 16, rsl, (fast && rk < 24) ? (ctl + CW_BAR3 + 128 * (8 * grp + (rk & 7))) : nullptr);
                    if (fast && rk < 24) quad_arrive(ctl + CW_GP + 64 * xbar.x);
                }
                else if (fast && rk >= 24) quad_arrive(ctl + CW_GP + 64 * xbar.x);
                if (kind == 1) {
                    const int sub = rk >> 3;
                    if (fast && sub != 2) quad_wait(ctl + CW_BAR3 + 128 * (8 * grp + (rk & 7)), 4u * qn, ctl + CW_BAR2 + XB_TMO);
                    if (sub == 3) { pg8::PairOrder S{8 * b + (rk & 7), 0, 2};
                        pg8::Gemm g{Pb + C_Q0, (const bf16_t*)(wl + WO_UQ), M, 512, 256, PLD, BLK}; pg8::EpiRope E{CQ, CQ_LD, rope, SSCQ}; pg8::gemm_phase(lds, g, S, E); }
                    else if (sub < 2) { pg8::PairOrder S{8 * b + (rk & 7), sub, 1};
                        pg8::Gemm g{Pb + C_KV0, (const bf16_t*)(wl + WO_UKV), M, 512, 128, PLD, BLK}; pg8::EpiBf16<0, 2> E{CKV, CKV_LD, SSCKV, 1.f / 128.f, nullptr}; pg8::gemm_phase(lds, g, S, E); }
                }
            } else if (kind == 2) {
                LAS unsigned* slot = (LAS unsigned*)(lds + LDS_MISC);
                int r0 = 0, r1 = 0, r2 = 0; bool ch_in = false;
                for (int j = 0; ; ++j) {
                    unsigned u; bool ch_out = false;
                    if (rk < 16 && j < 2) { u = 2u * rk + j; ch_out = (j == 0); }
                    else if (rk >= 16 && j < 3) { u = 32u + 3u * (rk - 16) + j;
                        ch_out = (j < 2) && ((((u - 32u) >> 3) / 3u) == (((u + 1u - 32u) >> 3) / 3u)); }
                    else {
                        if (tid == 0) *slot = atomicAdd(ctl + CW_Q + 64 * (8 * l + b), 1u);
                        __syncthreads();
                        u = 80u + *slot;
                        __syncthreads();
                        if (u >= 128u) break;
                    }
                    if (u < 32u) {
                        const int h = u >> 3, qb = u & 7;
                        AttnP P{CQ + h * 96, CQ_LD, CKV + h * 128, CKV_LD, Pb + C_R0, PLD, CKV + h * 128 + 64, CKV_LD, MIX + 768 + h * 64, DM, 0.f, 0.f};
                        attn_unit<2>(lds, P, b, qb, ch_in, ch_out, r0, r1, r2); ch_in = ch_out;
                    } else if (u < 80u) {
                        const int v = u - 32, h = v >> 3, qb = v & 7;
                        AttnP P{Pb + B_Q0 + h * 64, PLD, Pb + B_K0 + (h / 3) * 64, PLD, nullptr, 0, Pb + B_V0 + (h / 3) * 64, PLD, MIX + 384 + h * 64, DM, 0.f, 0.f};
                        attn_unit<1>(lds, P, b, qb, ch_in, ch_out, r0, r1, r2); ch_in = ch_out;
                    } else {
                        const int v = u - 80; int h, qb; if (v < 36) { h = v / 6; qb = 1 + v % 6; } else { h = (v - 36) >> 1; qb = ((v - 36) & 1) * 7; }
                        const float slope = exp2f(-8.0f * (float)(h + 1) / 6.0f);
                        AttnP P{Pb + A_Q0 + h * 64, PLD, Pb + A_K0 + (h / 3) * 64, PLD, nullptr, 0, Pb + A_V0 + (h / 3) * 64, PLD, MIX + h * 64, DM, slope * LOG2E, a_sink[l * 6 + h] * LOG2E};
                        attn_unit<0>(lds, P, b, qb, false, false, r0, r1, r2); ch_in = false;
                    }
                }
            } else if (kind == 5 && l == DEPTH - 1) {
                pg8::Gemm g{U, (const bf16_t*)(wl + WO_FF2), M, DM, FF, FF, BLK}; pg8::GroupOrder S; S.init(DM, b, rk, gsize);
                unsigned* qw = ctl + CW_BAR3 + 128 * (8 * grp + (rk & 7));
                EpiResFinal E{out, out, SSA, final_norm, DM, fast, qw, 4u * (qn + 1u), ctl + CW_BAR2 + XB_TMO, xbar}; pg8::gemm_phase(lds, g, S, E);
            } else if (kind == 3 || kind == 5) {
                const bool g3 = (kind == 3);
                pg8::Gemm g{g3 ? MIX : U, (const bf16_t*)(wl + (g3 ? WO_OUT : WO_FF2)), M, DM, g3 ? DM : FF, g3 ? DM : FF, BLK}; pg8::GroupOrder S; S.init(DM, b, rk, gsize);
                pg8::EpiRes E{(g3 && l == 0) ? x_in : (const float*)out, out, XN, g3 ? SSM : SSA, DM, g3 && l == 0}; pg8::gemm_phase(lds, g, S, E);
            } else if (kind == 4) {
                pg8::Gemm g{XN, (const bf16_t*)(wl + WO_FF1), M, FF, DM, DM, (size_t)256 * DM * 2}; pg8::GroupOrder S; S.init(FF, b, rk, gsize);
                LAS float* rsl = (LAS float*)(lds + LDS_MISC + 1024);
                pg8::EpiBf16<2, 0> E{U, FF, nullptr, 0.f, rsl}; pg8::gemm_phase(lds, g, S, E, SSM + (size_t)(8 * b + (rk & 7)) * 256 * 16, rsl);
            }
        }
        if (step + 1 < nsteps) {
            if (!fast) xcd_barrier(xbar);
            else if (kind == 1) {
                quad_arrive(ctl + CW_GA + 64 * xbar.x);
                if (rk >= 16) quad_wait(ctl + CW_GP + 64 * xbar.x, 32u * (unsigned)(l + 1), ctl + CW_BAR2 + XB_TMO);
                else quad_wait(ctl + CW_GA + 64 * xbar.x, 32u * (unsigned)(l + 1), ctl + CW_BAR2 + XB_TMO);
            }
            else if (kind == 2) local_barrier(ctl + CW_BAR2 + XB_XSUB(xbar.x), ctl + CW_BAR2 + XB_XGEN(xbar.x), ctl + CW_BAR2 + XB_TMO, 32u);
            else { unsigned* qw_ = ctl + CW_BAR3 + 128 * (8 * grp + (rk & 7));
                if (kind == 0) { if (rk >= 24) quad_arrive(qw_); ++qn; }
                else { quad_arrive(qw_); ++qn; quad_wait(qw_, 4u * qn, ctl + CW_BAR2 + XB_TMO); } }
        }
        }
    }
#undef PH_BEGIN
#undef PH_END_GROUP
#undef PH_END_QUAD
#undef PH_END_GRID
}


extern "C" void kernel_launch(void* const* d_in, const int* in_sizes, int n_in, void* d_out, int out_size, void* d_ws, size_t ws_size, hipStream_t stream) {
    static int grid = 0;
    if (grid == 0) {
        int dev = 0, cus = 0, per_cu = 0;
        hipGetDevice(&dev);
        hipDeviceGetAttribute(&cus, hipDeviceAttributeMultiprocessorCount, dev);
        if (hipFuncSetAttribute((const void*)fwd_kernel, hipFuncAttributeMaxDynamicSharedMemorySize, LDS_BYTES) != hipSuccess) { fprintf(stderr, "hipFuncSetAttribute failed\n"); }
        hipOccupancyMaxActiveBlocksPerMultiprocessor(&per_cu, (const void*)fwd_kernel, NTHREADS, LDS_BYTES);
        if (per_cu < 1) { fprintf(stderr, "occupancy query says %d\n", per_cu); per_cu = 1; }
        (void)hipGetLastError();
        grid = cus * 1;
        if (grid % 32 != 0) { fprintf(stderr, "this kernel needs a multiple of 32 workgroups (got %d)\n", grid); grid = -1; }
        if (grid > 0 && ws_size < WS_END) { fprintf(stderr, "workspace too small: %zu < %zu\n", ws_size, (size_t)WS_END); grid = -1; }
    }
    if (grid < 0) return;
    hipMemsetAsync((char*)d_ws + WS_CTL, 0, CTL_BYTES, stream);
    Args a{};
    for (int i = 0; i < 15; ++i) a.in[i] = (const float*)d_in[i];
    a.out = (float*)d_out; a.ws = (unsigned char*)d_ws;
    a.never = 0; a.pad = 0;
    void* kargs[] = {&a};
    hipError_t e = hipLaunchCooperativeKernel((const void*)fwd_kernel, dim3(grid), dim3(NTHREADS), kargs, LDS_BYTES, stream);
    if (e != hipSuccess) fprintf(stderr, "cooperative launch failed: %s (grid %d)\n", hipGetErrorString(e), grid);
}
```
